# Optimizing an MI355X kernel written in HIP

```python
import jax, jax.numpy as jnp
from jax import lax
import numpy as np

D_MODEL = 2048
BATCH = 4
SEQ = 2048
DEPTH = 2
DEC_BATCH = 128
DEC_SEQ = 8
PAST_LEN = 16384
PAGE_SIZE = 128

N_MIXERS = 2
N_CONV_LAYERS = (DEPTH + 1) // 2
N_SSD_LAYERS = DEPTH // 2
PLE_DIM = 256
D_FF = -(-8 * D_MODEL // (3 * 256)) * 256
SC_WIDTH = 3
D_INNER = 2 * D_MODEL
SSD_HEAD_DIM = 64
SSD_HEADS = D_INNER // SSD_HEAD_DIM
SSD_GROUPS = 8
SSD_STATE = 128
SSD_CONV = 4
SSD_GN = SSD_GROUPS * SSD_STATE
SSD_CONV_DIM = D_INNER + 2 * SSD_GN
SSD_IN_DIM = D_INNER + SSD_CONV_DIM + SSD_HEADS
SSD_CHUNK = 128
EPS = 1e-6

kernel_name = "hybrid_shortconv_ssd_decoder_step"


def rmsnorm(x, g):
    xf = x.astype(jnp.float32)
    xf = xf * lax.rsqrt(jnp.mean(xf * xf, axis=-1, keepdims=True) + EPS)
    return (xf * g.astype(jnp.float32)).astype(x.dtype)


def causal_dwconv(u, buf, w):
    K = w.shape[0]
    L = u.shape[1]
    up = jnp.concatenate([buf.astype(u.dtype), u], axis=1)
    out = up[:, 0:L] * w[0]
    for k in range(1, K):
        out = out + up[:, k:k + L] * w[k]
    return out, up[:, L:]


def short_conv_mixer(h, buf, w_in, w_conv, w_out):
    proj = h @ w_in
    bg, cg, v = jnp.split(proj, 3, axis=-1)
    u = cg * v
    conv, new_buf = causal_dwconv(u, buf, w_conv)
    return (bg * conv) @ w_out, new_buf


def ssd_scan(x, dt, A, Bm, Cm, h0):
    b, L, H, P = x.shape
    G, N = SSD_GROUPS, SSD_STATE
    R = H // G
    Q = SSD_CHUNK if L % SSD_CHUNK == 0 else L
    nc = L // Q
    f32 = jnp.float32
    xc = x.astype(f32).reshape(b, nc, Q, G, R, P)
    dtc = dt.reshape(b, nc, Q, G, R)
    Bc = Bm.astype(f32).reshape(b, nc, Q, G, N)
    Cc = Cm.astype(f32).reshape(b, nc, Q, G, N)
    a_cum = jnp.cumsum(dtc * A.reshape(G, R), axis=2)
    xdt = xc * dtc[..., None]
    causal = jnp.tril(jnp.ones((Q, Q), dtype=bool))
    seg = a_cum[:, :, :, None] - a_cum[:, :, None, :]
    decay = jnp.exp(jnp.where(causal[:, :, None, None], seg, -jnp.inf))
    cb = jnp.einsum('bctgn,bcsgn->bctsg', Cc, Bc)
    y_intra = jnp.einsum('bctsg,bctsgr,bcsgrp->bctgrp', cb, decay, xdt)
    decay_end = jnp.exp(a_cum[:, :, -1:] - a_cum)
    s_chunk = jnp.einsum('bcsgr,bcsgn,bcsgrp->bcgrpn', decay_end, Bc, xdt)
    chunk_decay = jnp.exp(a_cum[:, :, -1])

    def step(hs, inp):
        s_c, d_c = inp
        return d_c[..., None, None] * hs + s_c, hs

    h0g = h0.astype(f32).reshape(b, G, R, P, N)
    h_last, h_prev = lax.scan(step, h0g, (jnp.moveaxis(s_chunk, 1, 0), jnp.moveaxis(chunk_decay, 1, 0)))
    h_prev = jnp.moveaxis(h_prev, 0, 1)
    y_inter = jnp.einsum('bctgn,bcgrpn,bctgr->bctgrp', Cc, h_prev, jnp.exp(a_cum))
    y = (y_intra + y_inter).reshape(b, L, H, P).astype(x.dtype)
    return y, h_last.reshape(b, H, P, N).astype(h0.dtype)


def ssd_mixer(h, conv_buf, ssm_state, w_in, conv_w, conv_b, dt_bias, a_log, d_skip, norm_g, w_out):
    b, L, _ = h.shape
    zxbcdt = h @ w_in
    z = zxbcdt[..., :D_INNER]
    xbc = zxbcdt[..., D_INNER:D_INNER + SSD_CONV_DIM]
    dt_raw = zxbcdt[..., D_INNER + SSD_CONV_DIM:]
    xbc_c, new_conv = causal_dwconv(xbc, conv_buf, conv_w)
    xbc_c = jax.nn.silu(xbc_c + conv_b)
    xs = xbc_c[..., :D_INNER].reshape(b, L, SSD_HEADS, SSD_HEAD_DIM)
    Bm = xbc_c[..., D_INNER:D_INNER + SSD_GN].reshape(b, L, SSD_GROUPS, SSD_STATE)
    Cm = xbc_c[..., D_INNER + SSD_GN:].reshape(b, L, SSD_GROUPS, SSD_STATE)
    dt = jax.nn.softplus(dt_raw.astype(jnp.float32) + dt_bias.astype(jnp.float32))
    A = -jnp.exp(a_log.astype(jnp.float32))
    y, new_state = ssd_scan(xs, dt, A, Bm, Cm, ssm_state)
    y = y + xs * d_skip[:, None]
    gated = (y.reshape(b, L, D_INNER) * jax.nn.silu(z)).astype(jnp.float32)
    gated = gated.reshape(b, L, SSD_GROUPS, D_INNER // SSD_GROUPS)
    gated = gated * lax.rsqrt(jnp.mean(gated * gated, axis=-1, keepdims=True) + EPS)
    gated = gated * norm_g.astype(jnp.float32).reshape(SSD_GROUPS, -1)
    out = gated.reshape(b, L, D_INNER).astype(h.dtype) @ w_out
    return out, new_conv, new_state


def swiglu(h, w_gate, w_up, w_down):
    return (jax.nn.silu(h @ w_gate) * (h @ w_up)) @ w_down


def trunk(x, p, sc_bufs, ssd_bufs, ssd_states, g_mix, g_ffn, g_ple, g_final,
          sc_w_in, sc_w_conv, sc_w_out, ssd_w_in, ssd_conv_w, ssd_conv_b, ssd_dt_bias,
          ssd_a_log, ssd_d, ssd_norm_g, ssd_w_out, ffn_w_gate, ffn_w_up, ffn_w_down,
          ple_w_proj, ple_w_gate):
    h = x
    new_sc, new_ssd_conv, new_ssd = [], [], []
    for i in range(DEPTH):
        j = i // N_MIXERS
        hn = rmsnorm(h, g_mix[i])
        if i % N_MIXERS == 0:
            y, nb = short_conv_mixer(hn, sc_bufs[j], sc_w_in[j], sc_w_conv[j], sc_w_out[j])
            new_sc.append(nb)
        else:
            y, nc_, ns = ssd_mixer(hn, ssd_bufs[j], ssd_states[j], ssd_w_in[j], ssd_conv_w[j],
                                   ssd_conv_b[j], ssd_dt_bias[j], ssd_a_log[j], ssd_d[j],
                                   ssd_norm_g[j], ssd_w_out[j])
            new_ssd_conv.append(nc_)
            new_ssd.append(ns)
        h = h + y
        h = h + swiglu(rmsnorm(h, g_ffn[i]), ffn_w_gate[i], ffn_w_up[i], ffn_w_down[i])
        gate = jax.nn.sigmoid(rmsnorm(h, g_ple[i]) @ ple_w_gate[i])
        h = h + (p[i] @ ple_w_proj[i]) * gate
    return rmsnorm(h, g_final), jnp.stack(new_sc), jnp.stack(new_ssd_conv), jnp.stack(new_ssd)


def setup_inputs(seed: int = 0) -> dict:
    key = jax.random.key(seed)
    ks = jax.random.split(key, 32)
    f32 = jnp.float32
    nrm = lambda k, shape, s: jax.random.normal(k, shape, f32) * s
    dt0 = jnp.exp(jax.random.uniform(ks[17], (N_SSD_LAYERS, SSD_HEADS), f32)
                  * (np.log(0.1) - np.log(0.001)) + np.log(0.001))
    return {
        "x_prompt": nrm(ks[0], (BATCH, SEQ, D_MODEL), 1.0),
        "x_sample": nrm(ks[1], (DEC_BATCH, DEC_SEQ, D_MODEL), 1.0),
        "p_prompt": nrm(ks[2], (DEPTH, BATCH, SEQ, PLE_DIM), 1.0),
        "p_sample": nrm(ks[3], (DEPTH, DEC_BATCH, DEC_SEQ, PLE_DIM), 1.0),
        "state_sc_conv": nrm(ks[4], (N_CONV_LAYERS, DEC_BATCH, SC_WIDTH - 1, D_MODEL), 1.0),
        "state_ssd_conv": nrm(ks[5], (N_SSD_LAYERS, DEC_BATCH, SSD_CONV - 1, SSD_CONV_DIM), 1.0),
        "state_ssd": nrm(ks[6], (N_SSD_LAYERS, DEC_BATCH, SSD_HEADS, SSD_HEAD_DIM, SSD_STATE), 0.1),
        "g_mix": 1.0 + nrm(ks[7], (DEPTH, D_MODEL), 0.02),
        "g_ffn": 1.0 + nrm(ks[8], (DEPTH, D_MODEL), 0.02),
        "g_ple": 1.0 + nrm(ks[9], (DEPTH, D_MODEL), 0.02),
        "g_final": 1.0 + nrm(ks[10], (D_MODEL,), 0.02),
        "sc_w_in": nrm(ks[11], (N_CONV_LAYERS, D_MODEL, 3 * D_MODEL), D_MODEL ** -0.5),
        "sc_w_conv": nrm(ks[12], (N_CONV_LAYERS, SC_WIDTH, D_MODEL), SC_WIDTH ** -0.5),
        "sc_w_out": nrm(ks[13], (N_CONV_LAYERS, D_MODEL, D_MODEL), D_MODEL ** -0.5),
        "ssd_w_in": nrm(ks[14], (N_SSD_LAYERS, D_MODEL, SSD_IN_DIM), D_MODEL ** -0.5),
        "ssd_conv_w": nrm(ks[15], (N_SSD_LAYERS, SSD_CONV, SSD_CONV_DIM), SSD_CONV ** -0.5),
        "ssd_conv_b": nrm(ks[16], (N_SSD_LAYERS, SSD_CONV_DIM), 0.01),
        "ssd_dt_bias": dt0 + jnp.log(-jnp.expm1(-dt0)),
        "ssd_a_log": jnp.log(jax.random.uniform(ks[18], (N_SSD_LAYERS, SSD_HEADS), f32, 1.0, 16.0)),
        "ssd_d": 1.0 + nrm(ks[19], (N_SSD_LAYERS, SSD_HEADS), 0.02),
        "ssd_norm_g": 1.0 + nrm(ks[20], (N_SSD_LAYERS, D_INNER), 0.02),
        "ssd_w_out": nrm(ks[21], (N_SSD_LAYERS, D_INNER, D_MODEL), D_INNER ** -0.5),
        "ffn_w_gate": nrm(ks[22], (DEPTH, D_MODEL, D_FF), D_MODEL ** -0.5),
        "ffn_w_up": nrm(ks[23], (DEPTH, D_MODEL, D_FF), D_MODEL ** -0.5),
        "ffn_w_down": nrm(ks[24], (DEPTH, D_FF, D_MODEL), D_FF ** -0.5),
        "ple_w_proj": nrm(ks[25], (DEPTH, PLE_DIM, D_MODEL), PLE_DIM ** -0.5),
        "ple_w_gate": nrm(ks[26], (DEPTH, D_MODEL, D_MODEL), D_MODEL ** -0.5),
    }


def reference(x_prompt, x_sample, p_prompt, p_sample, state_sc_conv, state_ssd_conv, state_ssd,
              g_mix, g_ffn, g_ple, g_final, sc_w_in, sc_w_conv, sc_w_out, ssd_w_in, ssd_conv_w,
              ssd_conv_b, ssd_dt_bias, ssd_a_log, ssd_d, ssd_norm_g, ssd_w_out, ffn_w_gate,
              ffn_w_up, ffn_w_down, ple_w_proj, ple_w_gate):
    b0 = x_prompt.shape[0]
    dt_ = x_prompt.dtype
    sc0 = jnp.zeros((N_CONV_LAYERS, b0, SC_WIDTH - 1, D_MODEL), dt_)
    ssdc0 = jnp.zeros((N_SSD_LAYERS, b0, SSD_CONV - 1, SSD_CONV_DIM), dt_)
    ssd0 = jnp.zeros((N_SSD_LAYERS, b0, SSD_HEADS, SSD_HEAD_DIM, SSD_STATE), state_ssd.dtype)
    weights = (g_mix, g_ffn, g_ple, g_final, sc_w_in, sc_w_conv, sc_w_out, ssd_w_in, ssd_conv_w,
               ssd_conv_b, ssd_dt_bias, ssd_a_log, ssd_d, ssd_norm_g, ssd_w_out, ffn_w_gate,
               ffn_w_up, ffn_w_down, ple_w_proj, ple_w_gate)
    y_prompt, scp, ssdcp, ssdp = trunk(x_prompt, p_prompt, sc0, ssdc0, ssd0, *weights)
    y_sample, scs, ssdcs, ssds = trunk(x_sample, p_sample, state_sc_conv, state_ssd_conv, state_ssd, *weights)
    return (y_prompt, y_sample, scp, scs, ssdcp, ssdcs, ssdp, ssds)
```

```cpp
#include <hip/hip_runtime.h>
#include <hip/hip_cooperative_groups.h>
#include <cstdio>
#include <cstring>
namespace cg = cooperative_groups;

#define LAS __attribute__((address_space(3)))
typedef unsigned short bf16_t;
typedef short bf16x8 __attribute__((ext_vector_type(8)));
typedef float f32x4 __attribute__((ext_vector_type(4)));
typedef float f32x2 __attribute__((ext_vector_type(2)));
typedef unsigned u32x4 __attribute__((ext_vector_type(4)));
typedef unsigned u32x2 __attribute__((ext_vector_type(2)));

constexpr int NTOK = 9216, NPR = 8192, DM = 2048, DFF = 5632, DIN = 4096, CONVD = 6144, NSSD = 10304, NSSDP = 10496;
constexpr float EPSN = 1e-6f;
constexpr int LDS_BYTES = 157696 + 16;
constexpr int LDS_BAR_OFF = 157696;

constexpr size_t SZ_W1 = 6144ull * 2048 * 2, SZ_W2 = 2048ull * 2048 * 2, SZ_W3 = 11264ull * 2048 * 2, SZ_W4 = 2048ull * 5632 * 2,
                 SZ_W5 = SZ_W2, SZ_WP = 2048ull * 256 * 2, SZ_W6 = (size_t)NSSDP * 2048 * 2, SZ_W7 = 2048ull * 4096 * 2;
constexpr size_t O_W1 = 0, O_W2 = O_W1 + SZ_W1, O_W3 = O_W2 + SZ_W2, O_W4 = O_W3 + 2 * SZ_W3, O_W5 = O_W4 + 2 * SZ_W4, O_WP = O_W5 + 2 * SZ_W5,
                 O_W6 = O_WP + 2 * SZ_WP, O_W7 = O_W6 + SZ_W6;
constexpr size_t O_H = O_W7 + SZ_W7;
constexpr size_t O_HB = O_H + (size_t)NTOK * DM * 4;
constexpr size_t O_BG = O_HB + (size_t)NTOK * DM * 2;
constexpr size_t O_U = O_BG + (size_t)NTOK * DM * 2;
constexpr size_t O_XS = O_BG;
constexpr size_t O_ACT = O_U + (size_t)NTOK * DM * 2;
constexpr size_t O_A7 = O_ACT;
constexpr size_t O_PB = O_ACT + (size_t)NTOK * DFF * 2;
constexpr size_t O_PP = O_PB + 2ull * NTOK * 256 * 2;
constexpr size_t O_Z = O_PP + 2ull * NTOK * DM * 2;
constexpr size_t O_XBC = O_Z + (size_t)NTOK * DIN * 2;
constexpr size_t O_DT = O_XBC + (size_t)NTOK * CONVD * 2;
constexpr size_t O_CC = O_DT + (size_t)NTOK * 64 * 4;
constexpr size_t O_Y = O_CC + (size_t)NPR * 1024 * 2;
constexpr size_t O_SC = O_Y + (size_t)NTOK * DIN * 2;
constexpr size_t O_ACUM = O_SC + 4ull * 16 * 64 * 64 * 128 * 4;
constexpr size_t O_SS = O_ACUM + 4ull * 64 * 2048 * 4;
constexpr size_t O_BAR = O_SS + 7ull * NTOK * 4;
constexpr size_t BAR_BYTES = 3456 * 4;
constexpr size_t WS_END = O_BAR + BAR_BYTES;
static_assert(WS_END <= (1ull << 30), "workspace too large");

constexpr size_t OO_Y = 0, OO_SCP = (size_t)NTOK * DM, OO_SCS = OO_SCP + 4 * 2 * 2048, OO_SSDCP = OO_SCS + 128 * 2 * 2048,
                 OO_SSDCS = OO_SSDCP + 4 * 3 * CONVD, OO_SSDP = OO_SSDCS + 128 * 3 * CONVD, OO_SSDS = OO_SSDP + 4ull * 64 * 64 * 128;

struct Params { const float* in[27]; float* out; unsigned char* ws; };
enum { I_XP = 0, I_XS, I_PP, I_PS, I_SSC, I_SSDC, I_SSD, I_GMIX, I_GFFN, I_GPLE, I_GFIN, I_SCWIN, I_SCWCONV, I_SCWOUT, I_SSDWIN, I_SSDCONVW, I_SSDCONVB,
       I_DTB, I_ALOG, I_SSDD, I_NORMG, I_SSDWOUT, I_WGATE, I_WUP, I_WDOWN, I_PLEPROJ, I_PLEGATE };

__device__ __forceinline__ unsigned pk2(float lo, float hi) { unsigned r; asm volatile("v_cvt_pk_bf16_f32 %0, %1, %2" : "=v"(r) : "v"(lo), "v"(hi)); return r; }
__device__ __forceinline__ float bflo(unsigned w) { return __uint_as_float(w << 16); }
__device__ __forceinline__ float bfhi(unsigned w) { return __uint_as_float(w & 0xffff0000u); }
__device__ __forceinline__ float wave_sum(float v) {
#pragma unroll
    for (int o = 1; o < 64; o <<= 1) v += __shfl_xor(v, o);
    return v;
}
__device__ __forceinline__ float silu_f(float x) { return x * __builtin_amdgcn_rcpf(1.f + __expf(-x)); }
__device__ __forceinline__ float sigmoid_f(float x) { return __builtin_amdgcn_rcpf(1.f + __expf(-x)); }
__device__ __forceinline__ float softplus_f(float x) { return x > 20.f ? x : log1pf(__expf(x)); }
__device__ __forceinline__ void unpack8(const u32x4 w, float (&f)[8]) {
    f[0] = bflo(w.x); f[1] = bfhi(w.x); f[2] = bflo(w.y); f[3] = bfhi(w.y); f[4] = bflo(w.z); f[5] = bfhi(w.z); f[6] = bflo(w.w); f[7] = bfhi(w.w);
}
__device__ __forceinline__ u32x4 pack8(const float (&f)[8]) { u32x4 w; w.x = pk2(f[0], f[1]); w.y = pk2(f[2], f[3]); w.z = pk2(f[4], f[5]); w.w = pk2(f[6], f[7]); return w; }
#define LDS_FENCE() asm volatile("s_waitcnt lgkmcnt(0)" ::: "memory")
#define LDS_BARRIER() do { asm volatile("s_waitcnt lgkmcnt(0)" ::: "memory"); __builtin_amdgcn_s_barrier(); asm volatile("" ::: "memory"); } while (0)
__device__ __forceinline__ int opq(int x) { asm volatile("" : "+v"(x)); return x; }
__device__ __forceinline__ int opqs(int x) { asm volatile("" : "+s"(x)); return x; }
template <class T> __device__ __forceinline__ T* opqp(T* p) { asm volatile("" : "+s"(p)); return p; }


#define XB_TMO      128
#define XB_XCNT(j)  (256  + 64 * (j))
#define XB_XSUB(j)  (1280 + 64 * (j))
#define XB_XGEN(j)  (2304 + 64 * (j))
#define XB_TOP      3328
#define XB_TOPGEN   3392
#define XB_SPIN_CAP (1u << 18)
__device__ __forceinline__ unsigned xb_ld(unsigned* p)              { return __hip_atomic_load(p, __ATOMIC_RELAXED, __HIP_MEMORY_SCOPE_AGENT); }
__device__ __forceinline__ unsigned xb_add(unsigned* p, unsigned v) { return __hip_atomic_fetch_add(p, v, __ATOMIC_RELAXED, __HIP_MEMORY_SCOPE_AGENT); }
__device__ __forceinline__ unsigned xb_xcc_id() { return (unsigned)__builtin_amdgcn_s_getreg((3 << 11) | 20) & 0xFu; }
#define XB_SPIN(cond, bar) do { unsigned _sp = 0; while (cond) { __builtin_amdgcn_s_sleep(1); \
    if ((++_sp & 255u) == 0u) { if (xb_ld(&(bar)[XB_TMO])) break; if (_sp > XB_SPIN_CAP) { atomicAdd(&(bar)[XB_TMO], 1u); break; } } } } while (0)
__device__ __forceinline__ void xcd_barrier_complete(unsigned* bar, unsigned x, unsigned& nloc, unsigned& nx) {
    const unsigned G = gridDim.x * gridDim.y * gridDim.z;
    unsigned sum, cnt, mine, sp = 0u;
    for (;;) {
        sum = 0u; cnt = 0u; mine = 0u;
#pragma unroll
        for (unsigned j = 0; j < 16; ++j) { const unsigned c = xb_ld(&bar[XB_XCNT(j)]); sum += c; cnt += (c > 0u) ? 1u : 0u; mine = (j == x) ? c : mine; }
        if (sum == G) break;
        __builtin_amdgcn_s_sleep(1);
        if ((++sp & 255u) == 0u) { if (xb_ld(&bar[XB_TMO])) break; if (sp > XB_SPIN_CAP) { atomicAdd(&bar[XB_TMO], 1u); break; } }
    }
    nloc = mine > 0u ? mine : 1u; nx = cnt > 0u ? cnt : 1u;
}
__device__ __forceinline__ void xcd_barrier_post(unsigned* bar, volatile LAS unsigned* st) {
    if (threadIdx.x == 0) { st[0] = 0u; st[1] = 0u; (void)xb_add(&bar[XB_XCNT(xb_xcc_id())], 1u); }
    __syncthreads();
}
__device__ __forceinline__ void xcd_barrier(unsigned* bar, volatile LAS unsigned* st) {
    asm volatile("s_waitcnt vmcnt(0)" ::: "memory");
    __syncthreads();
    if (threadIdx.x == 0) {
        __builtin_amdgcn_s_waitcnt(0);
        const unsigned x = xb_xcc_id();
        unsigned nloc = st[0], nx = st[1];
        if (nloc == 0u) { xcd_barrier_complete(bar, x, nloc, nx); st[0] = nloc; st[1] = nx; }
        const unsigned old = xb_add(&bar[XB_XSUB(x)], 1u);
        const unsigned gen = old / nloc;
        if (old + 1u == (gen + 1u) * nloc) {
            __builtin_amdgcn_fence(__ATOMIC_RELEASE, "agent");
            asm volatile("s_waitcnt vmcnt(0)" ::: "memory");
            const unsigned og = xb_add(&bar[XB_TOP], 1u);
            const unsigned tg = og / nx;
            if (og + 1u == (tg + 1u) * nx) xb_add(&bar[XB_TOPGEN], 1u);
            else XB_SPIN(xb_ld(&bar[XB_TOPGEN]) == tg, bar);
            __builtin_amdgcn_fence(__ATOMIC_ACQUIRE, "agent");
            xb_add(&bar[XB_XGEN(x)], 1u);
            asm volatile("s_waitcnt vmcnt(0)" ::: "memory");
        } else {
            XB_SPIN(xb_ld(&bar[XB_XGEN(x)]) == gen, bar);
            __builtin_amdgcn_fence(__ATOMIC_ACQUIRE, "agent");
            asm volatile("s_waitcnt vmcnt(0)" ::: "memory");
        }
    }
    __syncthreads();
}

namespace pg8 {
constexpr int BM = 256, BK = 64, HALF = 128, HTB = HALF * BK * 2, STAGE_BYTES = 8 * HTB, NXCD = 8, WGM = 8;
__device__ __forceinline__ int lds_byte(int r, int c) { const int st = (r >> 4) * 2 + (c >> 5), rr = r & 15, cc = c & 31, ob = rr * 64 + cc * 2; return st * 1024 + (ob ^ (((ob >> 9) & 1) << 5)); }
__device__ __forceinline__ void stage_rc(int b, int& R, int& C) { const int st = b / 1024, sb = b % 1024, swz = sb ^ (((sb >> 9) & 1) << 5); R = (st >> 1) * 16 + swz / 64; C = (st & 1) * 32 + (swz % 64) / 2; }
__device__ __forceinline__ int perm32(int rho) { const int n = rho >> 4, i = rho & 15; return 8 * (i >> 2) + 4 * n + (i & 3); }
struct Unit { int pm, pn; };
struct Gemm { const bf16_t* A; const bf16_t* Bt; int M, N, K; };
struct StaticOrder {
    int nM, nN, nwg, G, c;
    __device__ void init(int M, int N, int G_, int c_) { nM = M / BM; nN = N / BM; nwg = nM * nN; G = G_; c = c_; }
    __device__ bool next(int i, Unit& u) const {
        const long L = (long)i * G + c; if (L >= nwg) return false;
        int wgid = (int)L; { const int q = nwg / NXCD, r = nwg % NXCD, xcd = wgid % NXCD, off = wgid / NXCD; wgid = (xcd < r ? xcd * (q + 1) : r * (q + 1) + (xcd - r) * q) + off; }
        const int nig = WGM * nN, gid = wgid / nig, fm = gid * WGM, gsz = (nM - fm) < WGM ? (nM - fm) : WGM;
        u.pm = fm + ((wgid % nig) % gsz); u.pn = (wgid % nig) / gsz; return true;
    }
};

template <class Epi>
__device__ __forceinline__ void gemm_phase(LAS unsigned char* lds, const Gemm g, const StaticOrder& S, const Epi& E) {
    const int tid = opq(threadIdx.x), wid = __builtin_amdgcn_readfirstlane(tid >> 6), lane = tid & 63, wr = wid >> 2, wc = wid & 3, fr = lane & 15, fq = lane >> 4;
    const int K = g.K, nt = K / BK;
    unsigned voffA[2], voffB[2];
#pragma unroll
    for (int i = 0; i < 2; ++i) { int R, C; stage_rc(tid * 16 + i * 8192, R, C); const int Rb = (R & ~31) + perm32(R & 31);
        voffA[i] = (unsigned)(R * K + C) * 2u; voffB[i] = (unsigned)(Rb * K + C) * 2u; }
    const size_t kstep = (size_t)(BK * 2);
    const size_t hstep = (size_t)HALF * K * 2;
    const size_t tstep = 2 * hstep;
    const unsigned ldsw = (unsigned)wid * 1024u;
    const int aoff = lds_byte(wr * 64 + fr, fq * 8), boff = lds_byte(wc * 32 + fr, fq * 8);
#define PG8_SA(b, h) (((b) * 2 + (h)) * HTB)
#define PG8_SB(b, h) ((4 + (b) * 2 + (h)) * HTB)
#define PG8_STAGE(bufoff, gbase, voff) do { _Pragma("unroll") for (int _i = 0; _i < 2; ++_i) \
        __builtin_amdgcn_global_load_lds((const unsigned*)((const char*)(gbase) + (voff)[_i]), (LAS unsigned*)(lds + (bufoff) + ldsw + _i * 8192), 16, 0, 0); } while (0)
#define PG8_LDA(dst, b, h) do { _Pragma("unroll") for (int m = 0; m < 4; ++m) _Pragma("unroll") for (int k = 0; k < 2; ++k) dst[m][k] = *(const LAS bf16x8*)(lds + PG8_SA(b, h) + aoff + m * 2048 + k * 1024); } while (0)
#define PG8_LDB(dst, b, h) do { _Pragma("unroll") for (int n = 0; n < 2; ++n) _Pragma("unroll") for (int k = 0; k < 2; ++k) dst[n][k] = *(const LAS bf16x8*)(lds + PG8_SB(b, h) + boff + n * 2048 + k * 1024); } while (0)
#define PG8_MMA(ai, bj, At, Bt) do { __builtin_amdgcn_s_setprio(1); _Pragma("unroll") for (int m = 0; m < 4; ++m) _Pragma("unroll") for (int n = 0; n < 2; ++n) _Pragma("unroll") for (int k = 0; k < 2; ++k) \
        acc[ai][bj][m][n] = __builtin_amdgcn_mfma_f32_16x16x32_bf16(Bt[n][k], At[m][k], acc[ai][bj][m][n], 0, 0, 0); __builtin_amdgcn_s_setprio(0); } while (0)
#define PG8_WAIT_V(n) asm volatile("s_waitcnt vmcnt(" #n ")" ::: "memory")
#define PG8_WAIT_L(n) asm volatile("s_waitcnt lgkmcnt(" #n ")" ::: "memory")
#define PG8_BAR __builtin_amdgcn_s_barrier()
#define PG8_SCHED __builtin_amdgcn_sched_barrier(0)
    Unit cur, nxt; int ui = 0;
    if (!S.next(0, cur)) return;
    f32x4 acc[2][2][4][2];
#pragma unroll
    for (int a = 0; a < 2; ++a)
#pragma unroll
        for (int b = 0; b < 2; ++b)
#pragma unroll
            for (int m = 0; m < 4; ++m)
#pragma unroll
                for (int n = 0; n < 2; ++n) acc[a][b][m][n] = (f32x4){0.f, 0.f, 0.f, 0.f};
    bf16x8 At[4][2], B0[2][2], B1[2][2];
    const char* cA = (const char*)g.A + (size_t)cur.pm * tstep; const char* cB = (const char*)g.Bt + (size_t)cur.pn * tstep;
    PG8_STAGE(PG8_SB(0, 0), cB, voffB); PG8_STAGE(PG8_SA(0, 0), cA, voffA); PG8_STAGE(PG8_SB(0, 1), cB + hstep, voffB); PG8_STAGE(PG8_SA(0, 1), cA + hstep, voffA);
    if (wr == 1) PG8_BAR;
    PG8_WAIT_V(4); PG8_BAR;
    PG8_STAGE(PG8_SB(1, 0), cB + kstep, voffB); PG8_STAGE(PG8_SA(1, 0), cA + kstep, voffA); PG8_STAGE(PG8_SB(1, 1), cB + hstep + kstep, voffB);
    PG8_WAIT_V(6); PG8_BAR;
    for (;;) {
        const bool has_next = S.next(ui + 1, nxt);
        const char* nA = has_next ? (const char*)g.A + (size_t)nxt.pm * tstep : cA; const char* nB = has_next ? (const char*)g.Bt + (size_t)nxt.pn * tstep : cB;
        for (int t = 0; t < nt; t += 2) {
            const bool last = (t == nt - 2);
            const char* a1 = cA + (size_t)(t + 1) * kstep;
            const char* a2 = last ? nA : cA + (size_t)(t + 2) * kstep; const char* b2 = last ? nB : cB + (size_t)(t + 2) * kstep;
            const char* a3 = a2 + kstep; const char* b3 = b2 + kstep;
            PG8_LDB(B0, 0, 0); PG8_SCHED; PG8_LDA(At, 0, 0); PG8_STAGE(PG8_SA(1, 1), a1 + hstep, voffA);
            PG8_WAIT_L(8); PG8_BAR; PG8_WAIT_L(0); PG8_MMA(0, 0, At, B0); PG8_BAR; PG8_SCHED;
            PG8_LDB(B1, 0, 1); PG8_STAGE(PG8_SB(0, 0), b2, voffB);
            PG8_BAR; PG8_WAIT_L(0); PG8_MMA(0, 1, At, B1); PG8_BAR;
            PG8_LDA(At, 0, 1); PG8_STAGE(PG8_SA(0, 0), a2, voffA);
            PG8_BAR; PG8_WAIT_L(0); PG8_MMA(1, 0, At, B0); PG8_BAR; PG8_SCHED;
            PG8_STAGE(PG8_SB(0, 1), b2 + hstep, voffB);
            PG8_WAIT_V(6); PG8_BAR; PG8_MMA(1, 1, At, B1); PG8_BAR;
            PG8_LDB(B0, 1, 0); PG8_SCHED; PG8_LDA(At, 1, 0); PG8_STAGE(PG8_SA(0, 1), a2 + hstep, voffA);
            PG8_WAIT_L(8); PG8_BAR; PG8_WAIT_L(0); PG8_MMA(0, 0, At, B0); PG8_BAR; PG8_SCHED;
            PG8_LDB(B1, 1, 1); PG8_STAGE(PG8_SB(1, 0), b3, voffB);
            PG8_BAR; PG8_WAIT_L(0); PG8_MMA(0, 1, At, B1); PG8_BAR;
            PG8_LDA(At, 1, 1); PG8_STAGE(PG8_SA(1, 0), a3, voffA);
            PG8_BAR; PG8_WAIT_L(0); PG8_MMA(1, 0, At, B0); PG8_BAR; PG8_SCHED;
            PG8_STAGE(PG8_SB(1, 1), b3 + hstep, voffB);
            PG8_WAIT_V(6); PG8_BAR; PG8_MMA(1, 1, At, B1); PG8_BAR;
        }
        E(acc, cur, wr, wc, fr, fq);
        if (!has_next) break;
#pragma unroll
        for (int a = 0; a < 2; ++a)
#pragma unroll
            for (int b = 0; b < 2; ++b)
#pragma unroll
                for (int m = 0; m < 4; ++m)
#pragma unroll
                    for (int n = 0; n < 2; ++n) acc[a][b][m][n] = (f32x4){0.f, 0.f, 0.f, 0.f};
        cur = nxt; cA = nA; cB = nB; ++ui;
    }
    PG8_WAIT_V(0);
    if (wr == 0) PG8_BAR;
    PG8_BAR;
#undef PG8_SA
#undef PG8_SB
#undef PG8_STAGE
#undef PG8_LDA
#undef PG8_LDB
#undef PG8_MMA
#undef PG8_WAIT_V
#undef PG8_WAIT_L
#undef PG8_BAR
#undef PG8_SCHED
}
}
using pg8::Unit;
typedef f32x4 AccT[2][2][4][2];

__device__ __forceinline__ float rstd_of(const float* ss, int r) { return rsqrtf(ss[r] * (1.f / DM) + EPSN); }

struct EpiScIn {
    const float* ss; bf16_t* BG; bf16_t* U; float* out_scp; float* out_scs;
    __device__ __forceinline__ void operator()(const AccT& acc, const Unit& u, int wr, int wc, int fr, int fq) const {
#pragma unroll
        for (int ai = 0; ai < 2; ++ai)
#pragma unroll
            for (int m = 0; m < 4; ++m) {
                const int r = u.pm * 256 + ai * 128 + wr * 64 + m * 16 + fr;
                const float rs = rstd_of(ss, r);
                if (u.pn < 8) {
#pragma unroll
                    for (int bj = 0; bj < 2; ++bj) {
                        const int c = u.pn * 256 + bj * 128 + wc * 32 + 8 * fq;
                        const f32x4 v0 = acc[ai][bj][m][0] * rs, v1 = acc[ai][bj][m][1] * rs;
                        u32x4 w; w.x = pk2(v0[0], v0[1]); w.y = pk2(v0[2], v0[3]); w.z = pk2(v1[0], v1[1]); w.w = pk2(v1[2], v1[3]);
                        *(u32x4*)(BG + (size_t)r * DM + c) = w;
                    }
                } else {
                    const int ch = (u.pn - 8) * 128 + wc * 32 + 8 * fq;
                    const float rs2 = rs * rs;
                    const f32x4 v0 = acc[ai][0][m][0] * acc[ai][1][m][0] * rs2, v1 = acc[ai][0][m][1] * acc[ai][1][m][1] * rs2;
                    u32x4 w; w.x = pk2(v0[0], v0[1]); w.y = pk2(v0[2], v0[3]); w.z = pk2(v1[0], v1[1]); w.w = pk2(v1[2], v1[3]);
                    *(u32x4*)(U + (size_t)r * DM + ch) = w;
                    float* o = nullptr;
                    if (r < NPR) { const int t = r & 2047; if (t >= 2046) o = out_scp + ((size_t)((r >> 11) * 2 + (t - 2046))) * DM + ch; }
                    else { const int rr = r - NPR, t = rr & 7; if (t >= 6) o = out_scs + ((size_t)((rr >> 3) * 2 + (t - 6))) * DM + ch; }
                    if (o) { *(f32x4*)o = v0; *(f32x4*)(o + 4) = v1; }
                }
            }
    }
};
struct EpiPlain {
    bf16_t* O;
    __device__ __forceinline__ void operator()(const AccT& acc, const Unit& u, int wr, int wc, int fr, int fq) const {
#pragma unroll
        for (int ai = 0; ai < 2; ++ai)
#pragma unroll
            for (int m = 0; m < 4; ++m) {
                const int r = u.pm * 256 + ai * 128 + wr * 64 + m * 16 + fr;
#pragma unroll
                for (int bj = 0; bj < 2; ++bj) {
                    const int c = u.pn * 256 + bj * 128 + wc * 32 + 8 * fq;
                    const f32x4 v0 = acc[ai][bj][m][0], v1 = acc[ai][bj][m][1];
                    u32x4 w; w.x = pk2(v0[0], v0[1]); w.y = pk2(v0[2], v0[3]); w.z = pk2(v1[0], v1[1]); w.w = pk2(v1[2], v1[3]);
                    *(u32x4*)(O + (size_t)r * DM + c) = w;
                }
            }
    }
};
template <int MODE> struct EpiRes {
    float* H; bf16_t* HB; float* ss_out; const float* ss_in; const bf16_t* PPl; const float* Hin;
    __device__ __forceinline__ void operator()(const AccT& acc, const Unit& u, int wr, int wc, int fr, int fq) const {
#pragma unroll
        for (int ai = 0; ai < 2; ++ai)
#pragma unroll
            for (int m = 0; m < 4; ++m) {
                const int r = u.pm * 256 + ai * 128 + wr * 64 + m * 16 + fr;
                float rs = 0.f; if (MODE == 1) rs = rstd_of(ss_in, r);
                float sq = 0.f;
#pragma unroll
                for (int bj = 0; bj < 2; ++bj) {
                    const int c = u.pn * 256 + bj * 128 + wc * 32 + 8 * fq;
                    float* hp = H + (size_t)r * DM + c; const float* hi = Hin + (size_t)r * DM + c;
                    f32x4 h0 = *(const f32x4*)hi, h1 = *(const f32x4*)(hi + 4);
                    f32x4 a0 = acc[ai][bj][m][0], a1 = acc[ai][bj][m][1];
                    if (MODE == 1) {
                        const u32x4 pw = *(const u32x4*)(PPl + (size_t)r * DM + c);
                        float pf[8]; unpack8(pw, pf);
#pragma unroll
                        for (int j = 0; j < 4; ++j) { a0[j] = pf[j] * sigmoid_f(a0[j] * rs); a1[j] = pf[4 + j] * sigmoid_f(a1[j] * rs); }
                    }
                    h0 += a0; h1 += a1;
                    *(f32x4*)hp = h0; *(f32x4*)(hp + 4) = h1;
                    u32x4 w; w.x = pk2(h0[0], h0[1]); w.y = pk2(h0[2], h0[3]); w.z = pk2(h1[0], h1[1]); w.w = pk2(h1[2], h1[3]);
                    if (HB) *(u32x4*)(HB + (size_t)r * DM + c) = w;
                    sq += h0[0] * h0[0] + h0[1] * h0[1] + h0[2] * h0[2] + h0[3] * h0[3] + h1[0] * h1[0] + h1[1] * h1[1] + h1[2] * h1[2] + h1[3] * h1[3];
                }
                sq += __shfl_xor(sq, 16); sq += __shfl_xor(sq, 32);
                if (fq == 0) atomicAdd(ss_out + r, sq);
            }
    }
};
struct EpiGateUp {
    const float* ss; bf16_t* ACT;
    __device__ __forceinline__ void operator()(const AccT& acc, const Unit& u, int wr, int wc, int fr, int fq) const {
#pragma unroll
        for (int ai = 0; ai < 2; ++ai)
#pragma unroll
            for (int m = 0; m < 4; ++m) {
                const int r = u.pm * 256 + ai * 128 + wr * 64 + m * 16 + fr;
                const float rs = rstd_of(ss, r);
                const int ch = u.pn * 128 + wc * 32 + 8 * fq;
                float o[8];
#pragma unroll
                for (int n = 0; n < 2; ++n)
#pragma unroll
                    for (int j = 0; j < 4; ++j) { const float gv = acc[ai][0][m][n][j] * rs, uv = acc[ai][1][m][n][j] * rs; o[4 * n + j] = silu_f(gv) * uv; }
                *(u32x4*)(ACT + (size_t)r * DFF + ch) = pack8(o);
            }
    }
};
struct EpiSsdIn {
    const float* ss; bf16_t* Z; bf16_t* XBC; float* DT; float* out_cp; float* out_cs;
    __device__ __forceinline__ void operator()(const AccT& acc, const Unit& u, int wr, int wc, int fr, int fq) const {
#pragma unroll
        for (int ai = 0; ai < 2; ++ai)
#pragma unroll
            for (int m = 0; m < 4; ++m) {
                const int r = u.pm * 256 + ai * 128 + wr * 64 + m * 16 + fr;
                const float rs = rstd_of(ss, r);
#pragma unroll
                for (int bj = 0; bj < 2; ++bj) {
                    const int c = u.pn * 256 + bj * 128 + wc * 32 + 8 * fq;
                    const f32x4 v0 = acc[ai][bj][m][0] * rs, v1 = acc[ai][bj][m][1] * rs;
                    u32x4 w; w.x = pk2(v0[0], v0[1]); w.y = pk2(v0[2], v0[3]); w.z = pk2(v1[0], v1[1]); w.w = pk2(v1[2], v1[3]);
                    if (u.pn < 16) { *(u32x4*)(Z + (size_t)r * DIN + c) = w; }
                    else if (u.pn < 40) {
                        const int cc = c - DIN;
                        *(u32x4*)(XBC + (size_t)r * CONVD + cc) = w;
                        float* o = nullptr;
                        if (r < NPR) { const int t = r & 2047; if (t >= 2045) o = out_cp + ((size_t)((r >> 11) * 3 + (t - 2045))) * CONVD + cc; }
                        else { const int rr = r - NPR, t = rr & 7; if (t >= 5) o = out_cs + ((size_t)((rr >> 3) * 3 + (t - 5))) * CONVD + cc; }
                        if (o) { *(f32x4*)o = v0; *(f32x4*)(o + 4) = v1; }
                    } else {
                        const int cd = c - (DIN + CONVD);
                        if (cd < 64) { float* o = DT + (size_t)r * 64 + cd; *(f32x4*)o = v0; *(f32x4*)(o + 4) = v1; }
                    }
                }
            }
    }
};


template <int MODE>
__device__ __forceinline__ void small_gemm_res(unsigned char* smem, const bf16_t* A, const bf16_t* Bt, const int K, float* H, const float* Hin, bf16_t* HB, float* ss_out, const float* ss_in, const bf16_t* PPl, const int unit) {
    LAS unsigned char* lds = (LAS unsigned char*)smem;
    const int tid = opq(threadIdx.x), lane = tid & 63, wid = __builtin_amdgcn_readfirstlane(tid >> 6), fr = lane & 15, fq = lane >> 4, wm = wid >> 1, wn = wid & 1;
    const int row0 = (unit & 7) * 128, col0 = (unit >> 3) * 64;
    constexpr int NST = 5, STB = 24576;
    unsigned voffA[2], voffB;
#pragma unroll
    for (int i = 0; i < 2; ++i) { int R, C; pg8::stage_rc(tid * 16 + i * 8192, R, C); voffA[i] = (unsigned)(R * K + C) * 2u; if (i == 0) voffB = (unsigned)(R * K + C) * 2u; }
    const char* gA = (const char*)(A + (size_t)row0 * K); const char* gB = (const char*)(Bt + (size_t)col0 * K);
    const unsigned ldsw = (unsigned)wid * 1024u;
    const int aoff = pg8::lds_byte(wm * 32 + fr, fq * 8), boff = 16384 + pg8::lds_byte(wn * 32 + fr, fq * 8);
    f32x4 acc[2][2];
#pragma unroll
    for (int m = 0; m < 2; ++m)
#pragma unroll
        for (int n = 0; n < 2; ++n) acc[m][n] = (f32x4){0.f, 0.f, 0.f, 0.f};
    const int nt = K >> 6;
#define SG_STAGE(slotoff, t) do { const size_t _ko = (size_t)(t) * 128; \
        __builtin_amdgcn_global_load_lds((const unsigned*)(gA + voffA[0] + _ko), (LAS unsigned*)(lds + (slotoff) + ldsw), 16, 0, 0); \
        __builtin_amdgcn_global_load_lds((const unsigned*)(gA + voffA[1] + _ko), (LAS unsigned*)(lds + (slotoff) + ldsw + 8192), 16, 0, 0); \
        __builtin_amdgcn_global_load_lds((const unsigned*)(gB + voffB + _ko), (LAS unsigned*)(lds + (slotoff) + 16384 + ldsw), 16, 0, 0); } while (0)
    asm volatile("s_waitcnt vmcnt(0)" ::: "memory"); __builtin_amdgcn_s_barrier();
    SG_STAGE(0 * STB, 0); SG_STAGE(1 * STB, 1); SG_STAGE(2 * STB, 2); SG_STAGE(3 * STB, 3);
    int cs = 0, ns = 4 * STB;
#pragma unroll 1
    for (int t = 0; t < nt; ++t) {
        asm volatile("s_waitcnt vmcnt(9)" ::: "memory"); __builtin_amdgcn_s_barrier();
        { const int tn = (t + 4 < nt) ? t + 4 : nt - 1; SG_STAGE(ns, tn); }
#pragma unroll
        for (int kk = 0; kk < 2; ++kk) { bf16x8 af[2], bfr[2];
#pragma unroll
            for (int m = 0; m < 2; ++m) af[m] = *(const LAS bf16x8*)(lds + cs + aoff + m * 2048 + kk * 1024);
#pragma unroll
            for (int n = 0; n < 2; ++n) bfr[n] = *(const LAS bf16x8*)(lds + cs + boff + n * 2048 + kk * 1024);
#pragma unroll
            for (int m = 0; m < 2; ++m)
#pragma unroll
                for (int n = 0; n < 2; ++n) acc[m][n] = __builtin_amdgcn_mfma_f32_16x16x32_bf16(bfr[n], af[m], acc[m][n], 0, 0, 0); }
        cs += STB; if (cs == NST * STB) cs = 0;
        ns += STB; if (ns == NST * STB) ns = 0;
    }
    asm volatile("s_waitcnt vmcnt(0)" ::: "memory"); __builtin_amdgcn_s_barrier();
#undef SG_STAGE
#pragma unroll
    for (int m = 0; m < 2; ++m) {
        const int r = NPR + row0 + wm * 32 + m * 16 + fr;
        float rs = 0.f; if (MODE == 1) rs = rstd_of(ss_in, r);
        float sq = 0.f;
#pragma unroll
        for (int n = 0; n < 2; ++n) {
            const int c = col0 + wn * 32 + n * 16 + 4 * fq;
            float* hp = H + (size_t)r * DM + c;
            f32x4 h0 = *(const f32x4*)(Hin + (size_t)r * DM + c); f32x4 a = acc[m][n];
            if (MODE == 1) { const u32x2 pw = *(const u32x2*)(PPl + (size_t)r * DM + c);
                a[0] = bflo(pw.x) * sigmoid_f(a[0] * rs); a[1] = bfhi(pw.x) * sigmoid_f(a[1] * rs); a[2] = bflo(pw.y) * sigmoid_f(a[2] * rs); a[3] = bfhi(pw.y) * sigmoid_f(a[3] * rs); }
            h0 += a;
            *(f32x4*)hp = h0;
            if (HB) { u32x2 w; w.x = pk2(h0[0], h0[1]); w.y = pk2(h0[2], h0[3]); *(u32x2*)(HB + (size_t)r * DM + c) = w; }
            sq += h0[0] * h0[0] + h0[1] * h0[1] + h0[2] * h0[2] + h0[3] * h0[3];
        }
        sq += __shfl_xor(sq, 16); sq += __shfl_xor(sq, 32);
        if (fq == 0) atomicAdd(ss_out + r, sq);
    }
}

struct CvtJob { const float* srcA; const float* srcB; const float* g; bf16_t* dst; int K, ld, nrows, nvalid, mode; };
__device__ __forceinline__ void cvt_item(const CvtJob& J, int item, float* scr, int lane) {
    const int nrb = J.nrows >> 6; const int kb = item / nrb, rb = item - kb * nrb; const int k0 = kb * 64, r0 = rb * 64;
    const float* src; bool valid = true;
    if (J.mode == 0) { src = J.srcA + r0; valid = r0 < J.nvalid; }
    else { const int uu = r0 >> 8, j = r0 & 255; src = (j < 128) ? J.srcA + uu * 128 + j : J.srcB + uu * 128 + (j - 128); }
    const int n2 = (lane & 31) * 2, kr = lane >> 5;
    const float* sp = src + (size_t)(k0 + kr) * J.ld + n2;
    f32x2 v[32];
#pragma unroll
    for (int i = 0; i < 32; ++i) v[i] = valid ? *(const f32x2*)(sp + (size_t)(2 * i) * J.ld) : (f32x2){0.f, 0.f};
    const int c = lane & 7;
    f32x4 g0 = (f32x4){1.f, 1.f, 1.f, 1.f}, g1 = g0;
    if (J.g) { g0 = *(const f32x4*)(J.g + k0 + 8 * c); g1 = *(const f32x4*)(J.g + k0 + 8 * c + 4); }
#pragma unroll
    for (int i = 0; i < 32; ++i) { scr[(2 * i + kr) * 65 + n2] = v[i].x; scr[(2 * i + kr) * 65 + n2 + 1] = v[i].y; }
    LDS_FENCE();
#pragma unroll
    for (int j = 0; j < 8; ++j) { const int n = (lane >> 3) + 8 * j; const float* s = scr + (8 * c) * 65 + n;
        u32x4 o; o.x = pk2(s[0 * 65] * g0[0], s[1 * 65] * g0[1]); o.y = pk2(s[2 * 65] * g0[2], s[3 * 65] * g0[3]); o.z = pk2(s[4 * 65] * g1[0], s[5 * 65] * g1[1]); o.w = pk2(s[6 * 65] * g1[2], s[7 * 65] * g1[3]);
        *(u32x4*)(J.dst + (size_t)(r0 + n) * J.K + k0 + 8 * c) = o; }
    LDS_FENCE();
}
constexpr int NJOBS = 13;
__device__ __forceinline__ CvtJob get_job(const Params& P, int j) {
    CvtJob J; J.srcB = nullptr; J.g = nullptr; J.mode = 0;
    unsigned char* ws = opqp(P.ws);
    switch (j) {
    case 0: J.srcA = P.in[I_SCWIN]; J.g = P.in[I_GMIX]; J.dst = (bf16_t*)(ws + O_W1); J.K = 2048; J.ld = 6144; J.nrows = 2048; J.nvalid = 2048; break;
    case 1: J.srcA = P.in[I_SCWIN] + 2048; J.srcB = P.in[I_SCWIN] + 4096; J.g = P.in[I_GMIX]; J.dst = (bf16_t*)(ws + O_W1) + (size_t)2048 * 2048; J.K = 2048; J.ld = 6144; J.nrows = 4096; J.nvalid = 4096; J.mode = 1; break;
    case 2: J.srcA = P.in[I_SCWOUT]; J.dst = (bf16_t*)(ws + O_W2); J.K = 2048; J.ld = 2048; J.nrows = 2048; J.nvalid = 2048; break;
    case 3: case 4: { const int l = j - 3; J.srcA = P.in[I_WGATE] + (size_t)l * DM * DFF; J.srcB = P.in[I_WUP] + (size_t)l * DM * DFF; J.g = P.in[I_GFFN] + l * DM;
        J.dst = (bf16_t*)(ws + O_W3 + l * SZ_W3); J.K = 2048; J.ld = DFF; J.nrows = 11264; J.nvalid = 11264; J.mode = 1; break; }
    case 5: case 6: { const int l = j - 5; J.srcA = P.in[I_WDOWN] + (size_t)l * DFF * DM; J.dst = (bf16_t*)(ws + O_W4 + l * SZ_W4); J.K = DFF; J.ld = 2048; J.nrows = 2048; J.nvalid = 2048; break; }
    case 7: case 8: { const int l = j - 7; J.srcA = P.in[I_PLEGATE] + (size_t)l * DM * DM; J.g = P.in[I_GPLE] + l * DM; J.dst = (bf16_t*)(ws + O_W5 + l * SZ_W5); J.K = 2048; J.ld = 2048; J.nrows = 2048; J.nvalid = 2048; break; }
    case 9: case 10: { const int l = j - 9; J.srcA = P.in[I_PLEPROJ] + (size_t)l * 256 * DM; J.dst = (bf16_t*)(ws + O_WP + l * SZ_WP); J.K = 256; J.ld = 2048; J.nrows = 2048; J.nvalid = 2048; break; }
    case 11: J.srcA = P.in[I_SSDWIN]; J.g = P.in[I_GMIX] + DM; J.dst = (bf16_t*)(ws + O_W6); J.K = 2048; J.ld = NSSD; J.nrows = NSSDP; J.nvalid = NSSD; break;
    default: J.srcA = P.in[I_SSDWOUT]; J.dst = (bf16_t*)(ws + O_W7); J.K = 4096; J.ld = 2048; J.nrows = 2048; J.nvalid = 2048; break;
    }
    return J;
}
__device__ __forceinline__ int job_items(int j) {
    switch (j) { case 0: return 32 * 32; case 1: return 32 * 64; case 2: return 32 * 32; case 3: case 4: return 32 * 176; case 5: case 6: return 88 * 32;
                 case 7: case 8: return 32 * 32; case 9: case 10: return 4 * 32; case 11: return 32 * 164; default: return 64 * 32; }
}
__device__ __forceinline__ void cvt_jobs(const Params& P, unsigned char* smem, const unsigned mask, const int widx, const int nw) {
    const int tidq = opq(threadIdx.x); const int lane = tidq & 63, wave = tidq >> 6;
    float* scr = (float*)(smem) + wave * (64 * 65);
    int base = 0;
#pragma unroll 1
    for (int j = 0; j < NJOBS; ++j) {
        if (!((mask >> j) & 1u)) continue;
        const CvtJob J = get_job(P, j); const int ni = job_items(j);
        int first = (widx - (base % nw) + nw) % nw;
        for (int it = first; it < ni; it += nw) cvt_item(J, it, scr, lane);
        base += ni;
    }
}
__device__ __forceinline__ void phase0(const Params& P, unsigned char* smem) {
    const int tid = opq(threadIdx.x), lane = tid & 63, wave = tid >> 6;
    const int gw = blockIdx.x * 8 + wave, NGW = 2048;
    unsigned char* ws = opqp(P.ws);
    float* H = (float*)(ws + O_H); bf16_t* HB = (bf16_t*)(ws + O_HB); float* SS = (float*)(ws + O_SS);
    for (int r = gw; r < NTOK; r += NGW) {
        const float* xr = (r < NPR) ? P.in[I_XP] + (size_t)r * DM : P.in[I_XS] + (size_t)(r - NPR) * DM;
        float s = 0.f;
#pragma unroll
        for (int j = 0; j < 8; ++j) { const int c = (j * 64 + lane) * 4; const f32x4 v = *(const f32x4*)(xr + c);
            u32x2 w; w.x = pk2(v[0], v[1]); w.y = pk2(v[2], v[3]); *(u32x2*)(HB + (size_t)r * DM + c) = w;
            s += v[0] * v[0] + v[1] * v[1] + v[2] * v[2] + v[3] * v[3]; }
        s = wave_sum(s);
        if (lane == 0) SS[r] = s;
    }
    const int gt = blockIdx.x * 512 + tid, NGT = 131072;
    for (int i = gt; i < 6 * NTOK; i += NGT) SS[NTOK + i] = 0.f;
    bf16_t* PB = (bf16_t*)(ws + O_PB);
    for (int i = gt; i < 2 * NTOK * 64; i += NGT) {
        const int l = i / (NTOK * 64), rem = i - l * (NTOK * 64), r = rem >> 6, c = (rem & 63) * 4;
        const float* src = (r < NPR) ? P.in[I_PP] + ((size_t)l * NPR + r) * 256 + c : P.in[I_PS] + ((size_t)l * 1024 + (r - NPR)) * 256 + c;
        const f32x4 v = *(const f32x4*)src; u32x2 w; w.x = pk2(v[0], v[1]); w.y = pk2(v[2], v[3]);
        *(u32x2*)(PB + ((size_t)l * NTOK + r) * 256 + c) = w;
    }
    cvt_jobs(P, smem, 0x60F, gw, NGW);
}

__device__ __forceinline__ void sc_conv_phase(const Params& P) {
    unsigned char* ws = opqp(P.ws); bf16_t* BG = (bf16_t*)(ws + O_BG); const bf16_t* U = (const bf16_t*)(ws + O_U);
    const float* wc = P.in[I_SCWCONV]; const float* buf = P.in[I_SSC];
    const int gt = opq(threadIdx.x) + blockIdx.x * 512, NGT = 131072;
    for (int i = gt; i < (NTOK / 4) * 256; i += NGT) {
        const int rb = i >> 8, ch = (i & 255) * 8, r0 = rb * 4;
        float w0[8], w1[8], w2[8];
#pragma unroll
        for (int e = 0; e < 8; e += 4) { *(f32x4*)(w0 + e) = *(const f32x4*)(wc + ch + e); *(f32x4*)(w1 + e) = *(const f32x4*)(wc + DM + ch + e); *(f32x4*)(w2 + e) = *(const f32x4*)(wc + 2 * DM + ch + e); }
        float um2[8], um1[8];
        const bool pr = r0 < NPR; const int t0 = pr ? (r0 & 2047) : ((r0 - NPR) & 7);
        if (t0 == 0) {
            if (pr) {
#pragma unroll
                for (int e = 0; e < 8; ++e) { um2[e] = 0.f; um1[e] = 0.f; }
            } else { const int b = (r0 - NPR) >> 3;
#pragma unroll
                for (int e = 0; e < 8; e += 4) { *(f32x4*)(um2 + e) = *(const f32x4*)(buf + ((size_t)b * 2 + 0) * DM + ch + e); *(f32x4*)(um1 + e) = *(const f32x4*)(buf + ((size_t)b * 2 + 1) * DM + ch + e); } }
        } else {
            unpack8(*(const u32x4*)(U + (size_t)(r0 - 2) * DM + ch), um2); unpack8(*(const u32x4*)(U + (size_t)(r0 - 1) * DM + ch), um1);
        }
#pragma unroll
        for (int j = 0; j < 4; ++j) {
            float uc[8], bg[8], o[8];
            unpack8(*(const u32x4*)(U + (size_t)(r0 + j) * DM + ch), uc); unpack8(*(const u32x4*)(BG + (size_t)(r0 + j) * DM + ch), bg);
#pragma unroll
            for (int e = 0; e < 8; ++e) { o[e] = bg[e] * (w0[e] * um2[e] + w1[e] * um1[e] + w2[e] * uc[e]); um2[e] = um1[e]; um1[e] = uc[e]; }
            *(u32x4*)(BG + (size_t)(r0 + j) * DM + ch) = pack8(o);
        }
    }
}

constexpr int LST = 136;
__device__ __forceinline__ bf16x8 lds_frag(const bf16_t* base, int row, int col) { return *(const bf16x8*)(base + row * LST + col); }

__device__ __forceinline__ void ssd_prompt_item(const Params& P, int item, unsigned char* smem) {
    const int tid = opq(threadIdx.x), lane = tid & 63, wid = tid >> 6, fr = lane & 15, fq = lane >> 4;
    const int g = item & 7, c = (item >> 3) & 15, b = item >> 7;
    const int row0 = b * 2048 + c * 128;
    unsigned char* ws = opqp(P.ws);
    const bf16_t* XBC = (const bf16_t*)(ws + O_XBC); const float* DT = (const float*)(ws + O_DT);
    bf16_t* CC = (bf16_t*)(ws + O_CC); bf16_t* XS = (bf16_t*)(ws + O_XS); bf16_t* Y = (bf16_t*)(ws + O_Y); float* SC = (float*)(ws + O_SC); float* ACUM = (float*)(ws + O_ACUM);
    const float* cw = P.in[I_SSDCONVW]; const float* cb = P.in[I_SSDCONVB];
    bf16_t* Cs = (bf16_t*)(smem); bf16_t* Bs = (bf16_t*)(smem + 34816); bf16_t* BTs = (bf16_t*)(smem + 2 * 34816); bf16_t* CBs = (bf16_t*)(smem + 3 * 34816);
    bf16_t* XT = Cs; bf16_t* XD = (bf16_t*)(smem + 17408);
    float* acs_all = (float*)(smem + 4 * 34816); float* dts_all = acs_all + 1024; float* wts = dts_all + 1024;
    {
        const int h = g * 8 + wid;
        const float A = -__expf(P.in[I_ALOG][h]); const float db = P.in[I_DTB][h];
        const float d0 = softplus_f(DT[(size_t)(row0 + 2 * lane) * 64 + h] + db), d1 = softplus_f(DT[(size_t)(row0 + 2 * lane + 1) * 64 + h] + db);
        const float a0 = d0 * A, a1 = d1 * A; float s = a0 + a1;
#pragma unroll
        for (int o = 1; o < 64; o <<= 1) { const float v = __shfl_up(s, o); if (lane >= o) s += v; }
        acs_all[wid * 128 + 2 * lane] = s - a1; acs_all[wid * 128 + 2 * lane + 1] = s; dts_all[wid * 128 + 2 * lane] = d0; dts_all[wid * 128 + 2 * lane + 1] = d1;
        f32x2 av; av.x = s - a1; av.y = s;
        *(f32x2*)(ACUM + ((size_t)(b * 64 + h)) * 2048 + c * 128 + 2 * lane) = av;
#pragma unroll
        for (int k = 0; k < 4; ++k) wts[k * 512 + tid] = cw[(size_t)k * CONVD + g * 512 + tid];
        wts[4 * 512 + tid] = cb[g * 512 + tid];
    }
    {
        const int n0 = (tid & 15) * 8, r = tid >> 4;
#pragma unroll 1
        for (int mat = 0; mat < 2; ++mat) {
            const int ch = DIN + mat * 1024 + g * 128 + n0;
            float w[4][8], bias[8];
#pragma unroll
            for (int k = 0; k < 4; ++k) { *(f32x4*)(w[k]) = *(const f32x4*)(cw + (size_t)k * CONVD + ch); *(f32x4*)(w[k] + 4) = *(const f32x4*)(cw + (size_t)k * CONVD + ch + 4); }
            *(f32x4*)(bias) = *(const f32x4*)(cb + ch); *(f32x4*)(bias + 4) = *(const f32x4*)(cb + ch + 4);
            u32x4 xr[7];
#pragma unroll
            for (int j = 0; j < 7; ++j) { const int t = 4 * r - 3 + j; const bool ok = (c > 0) || (t >= 0);
                xr[j] = ok ? *(const u32x4*)(XBC + (size_t)(row0 + t) * CONVD + ch) : (u32x4){0u, 0u, 0u, 0u}; }
            float o[4][8];
#pragma unroll
            for (int i = 0; i < 4; ++i) {
                float x0[8], x1[8], x2[8], x3[8]; unpack8(xr[i], x0); unpack8(xr[i + 1], x1); unpack8(xr[i + 2], x2); unpack8(xr[i + 3], x3);
#pragma unroll
                for (int e = 0; e < 8; ++e) o[i][e] = silu_f(w[0][e] * x0[e] + w[1][e] * x1[e] + w[2][e] * x2[e] + w[3][e] * x3[e] + bias[e]);
            }
            if (mat == 0) {
#pragma unroll
                for (int i = 0; i < 4; ++i) *(u32x4*)(Bs + (4 * r + i) * LST + n0) = pack8(o[i]);
#pragma unroll
                for (int e = 0; e < 8; ++e) { u32x2 w2; w2.x = pk2(o[0][e], o[1][e]); w2.y = pk2(o[2][e], o[3][e]); *(u32x2*)(BTs + (n0 + e) * LST + 4 * r) = w2; }
            } else {
#pragma unroll
                for (int i = 0; i < 4; ++i) { const u32x4 pw = pack8(o[i]); *(u32x4*)(Cs + (4 * r + i) * LST + n0) = pw; *(u32x4*)(CC + (size_t)(row0 + 4 * r + i) * 1024 + g * 128 + n0) = pw; }
            }
        }
    }
    const int p0 = (tid & 7) * 8, xr_r = tid >> 3;
    u32x4 xr[5];
#pragma unroll
    for (int j = 0; j < 5; ++j) { const int t = 2 * xr_r - 3 + j; const bool ok = (c > 0) || (t >= 0);
        xr[j] = ok ? *(const u32x4*)(XBC + (size_t)(row0 + t) * CONVD + (g * 8) * 64 + p0) : (u32x4){0u, 0u, 0u, 0u}; }
    LDS_BARRIER();
    {
        f32x4 acc[8];
#pragma unroll
        for (int j = 0; j < 8; ++j) acc[j] = (f32x4){0.f, 0.f, 0.f, 0.f};
#pragma unroll
        for (int kk = 0; kk < 4; ++kk) {
            const bf16x8 a = lds_frag(Cs, 16 * wid + fr, 32 * kk + 8 * fq);
#pragma unroll
            for (int j = 0; j < 8; ++j) if (j <= wid) { const bf16x8 bb = lds_frag(Bs, 16 * j + fr, 32 * kk + 8 * fq); acc[j] = __builtin_amdgcn_mfma_f32_16x16x32_bf16(bb, a, acc[j], 0, 0, 0); }
        }
#pragma unroll
        for (int j = 0; j < 8; ++j) if (j <= wid) { u32x2 w2; w2.x = pk2(acc[j][0], acc[j][1]); w2.y = pk2(acc[j][2], acc[j][3]); *(u32x2*)(CBs + (16 * wid + fr) * LST + 16 * j + 4 * fq) = w2; }
    }
    LDS_BARRIER();
#pragma unroll 1
    for (int hh = 0; hh < 8; ++hh) {
        const int h = g * 8 + hh;
        const float* acs = acs_all + hh * 128; const float* dts = dts_all + hh * 128;
        {
            const int r = xr_r; const int ch = h * 64 + p0;
            float o[2][8];
            {
                float w[4][8], bias[8];
#pragma unroll
                for (int k = 0; k < 4; ++k) { *(f32x4*)(w[k]) = *(const f32x4*)(wts + k * 512 + hh * 64 + p0); *(f32x4*)(w[k] + 4) = *(const f32x4*)(wts + k * 512 + hh * 64 + p0 + 4); }
                *(f32x4*)(bias) = *(const f32x4*)(wts + 4 * 512 + hh * 64 + p0); *(f32x4*)(bias + 4) = *(const f32x4*)(wts + 4 * 512 + hh * 64 + p0 + 4);
#pragma unroll
                for (int i = 0; i < 2; ++i) {
                    float x0[8], x1[8], x2[8], x3[8]; unpack8(xr[i], x0); unpack8(xr[i + 1], x1); unpack8(xr[i + 2], x2); unpack8(xr[i + 3], x3);
#pragma unroll
                    for (int e = 0; e < 8; ++e) o[i][e] = silu_f(w[0][e] * x0[e] + w[1][e] * x1[e] + w[2][e] * x2[e] + w[3][e] * x3[e] + bias[e]);
                }
            }
            if (hh < 7) {
#pragma unroll
                for (int j = 0; j < 5; ++j) { const int t = 2 * r - 3 + j; const bool ok = (c > 0) || (t >= 0);
                    xr[j] = ok ? *(const u32x4*)(XBC + (size_t)(row0 + t) * CONVD + (h + 1) * 64 + p0) : (u32x4){0u, 0u, 0u, 0u}; }
            }
            const float aend = acs[127];
            const float d0 = dts[2 * r], d1 = dts[2 * r + 1];
            const float e0 = d0 * __expf(aend - acs[2 * r]), e1 = d1 * __expf(aend - acs[2 * r + 1]);
#pragma unroll
            for (int e = 0; e < 8; ++e) {
                *(unsigned*)(XT + (p0 + e) * LST + 2 * r) = pk2(o[0][e] * d0, o[1][e] * d1);
                *(unsigned*)(XD + (p0 + e) * LST + 2 * r) = pk2(o[0][e] * e0, o[1][e] * e1);
            }
        }
        LDS_BARRIER();
        {
            const int t = 16 * wid + fr; const float at = acs[t];
            const float dsk = P.in[I_SSDD][h] * __builtin_amdgcn_rcpf(fmaxf(dts[t], 1e-30f));
            f32x4 acc[4];
#pragma unroll
            for (int j = 0; j < 4; ++j) acc[j] = (f32x4){0.f, 0.f, 0.f, 0.f};
#pragma unroll
            for (int kk = 0; kk < 4; ++kk) if (32 * kk <= 16 * wid + 15) {
                const int s0 = 32 * kk + 8 * fq;
                float cbv[8]; unpack8(*(const u32x4*)(CBs + t * LST + s0), cbv);
                float as[8]; *(f32x4*)(as) = *(const f32x4*)(acs + s0); *(f32x4*)(as + 4) = *(const f32x4*)(acs + s0 + 4);
                float mv[8];
#pragma unroll
                for (int e = 0; e < 8; ++e) mv[e] = (s0 + e < t) ? cbv[e] * __expf(at - as[e]) : ((s0 + e == t) ? cbv[e] + dsk : 0.f);
                const u32x4 mp = pack8(mv); const bf16x8 a = *(const bf16x8*)&mp;
#pragma unroll
                for (int j = 0; j < 4; ++j) { const bf16x8 bb = lds_frag(XT, 16 * j + fr, 32 * kk + 8 * fq); acc[j] = __builtin_amdgcn_mfma_f32_16x16x32_bf16(bb, a, acc[j], 0, 0, 0); }
            }
#pragma unroll
            for (int j = 0; j < 4; ++j) { u32x2 w2; w2.x = pk2(acc[j][0], acc[j][1]); w2.y = pk2(acc[j][2], acc[j][3]);
                *(u32x2*)(Y + (size_t)(row0 + t) * DIN + h * 64 + 16 * j + 4 * fq) = w2; }
        }
        {
            f32x4 acc[4];
#pragma unroll
            for (int j = 0; j < 4; ++j) acc[j] = (f32x4){0.f, 0.f, 0.f, 0.f};
#pragma unroll
            for (int kk = 0; kk < 4; ++kk) {
                const bf16x8 xb = lds_frag(BTs, 16 * wid + fr, 32 * kk + 8 * fq);
#pragma unroll
                for (int j = 0; j < 4; ++j) { const bf16x8 yb = lds_frag(XD, 16 * j + fr, 32 * kk + 8 * fq); acc[j] = __builtin_amdgcn_mfma_f32_16x16x32_bf16(xb, yb, acc[j], 0, 0, 0); }
            }
            bf16_t* scb = (bf16_t*)SC + ((size_t)((b * 16 + c) * 64 + h)) * 64 * 128;
#pragma unroll
            for (int j = 0; j < 4; ++j) { u32x2 w2; w2.x = pk2(acc[j][0], acc[j][1]); w2.y = pk2(acc[j][2], acc[j][3]); *(u32x2*)(scb + (size_t)(16 * j + fr) * 128 + 16 * wid + 4 * fq) = w2; }
        }
        LDS_BARRIER();
    }
}

__device__ __forceinline__ void ssd_sample_item(const Params& P, int item, unsigned char* smem) {
    const int tid = opq(threadIdx.x), lane = tid & 63, wid = tid >> 6, fr = lane & 15, fq = lane >> 4;
    const int g = item & 7, b = item >> 3, h = g * 8 + wid;
    const int R0 = NPR + b * 8;
    unsigned char* ws = opqp(P.ws);
    const bf16_t* XBC = (const bf16_t*)(ws + O_XBC); const float* DT = (const float*)(ws + O_DT); bf16_t* Y = (bf16_t*)(ws + O_Y);
    const float* cw = P.in[I_SSDCONVW]; const float* cbias = P.in[I_SSDCONVB]; const float* cbuf = P.in[I_SSDC] + (size_t)b * 3 * CONVD;
    const float* st_in = P.in[I_SSD] + ((size_t)(b * 64 + h)) * 64 * 128; float* st_out = P.out + OO_SSDS + ((size_t)(b * 64 + h)) * 64 * 128;
    float* Bsm = (float*)smem;
    float* Csm = Bsm + 1024;
    float* cbs = Csm + 1024;
    float* yis = cbs + 64 + wid * 512;
    bf16_t* C16 = (bf16_t*)(smem + 24832);
    bf16_t* BT16 = C16 + 1024;
    bf16_t* xw16 = BT16 + 1024 + wid * 512;
    LDS_BARRIER();
    {
        const int mat = tid >> 8, t = (tid >> 5) & 7, n4 = (tid & 31) * 4;
        const int ch = DIN + mat * 1024 + g * 128 + n4;
        f32x4 accv = *(const f32x4*)(cbias + ch);
#pragma unroll
        for (int k = 0; k < 4; ++k) {
            const int j = t + k; f32x4 xv;
            if (j < 3) xv = *(const f32x4*)(cbuf + (size_t)j * CONVD + ch);
            else { const u32x2 pw = *(const u32x2*)(XBC + (size_t)(R0 + j - 3) * CONVD + ch); xv = (f32x4){bflo(pw.x), bfhi(pw.x), bflo(pw.y), bfhi(pw.y)}; }
            accv += *(const f32x4*)(cw + (size_t)k * CONVD + ch) * xv;
        }
        f32x4 o; o[0] = silu_f(accv[0]); o[1] = silu_f(accv[1]); o[2] = silu_f(accv[2]); o[3] = silu_f(accv[3]);
        *(f32x4*)((mat ? Csm : Bsm) + t * 128 + n4) = o;
        const unsigned p01 = pk2(o[0], o[1]), p23 = pk2(o[2], o[3]);
        if (mat) { u32x2 w2; w2.x = p01; w2.y = p23; *(u32x2*)(C16 + t * 128 + n4) = w2; }
        else { BT16[(n4 + 0) * 8 + t] = (bf16_t)(p01 & 0xffffu); BT16[(n4 + 1) * 8 + t] = (bf16_t)(p01 >> 16); BT16[(n4 + 2) * 8 + t] = (bf16_t)(p23 & 0xffffu); BT16[(n4 + 3) * 8 + t] = (bf16_t)(p23 >> 16); }
    }
    float xs[8], dtv[8], ac[8];
    {
        const int ch = h * 64 + lane;
        float up[11];
#pragma unroll
        for (int j = 0; j < 3; ++j) up[j] = cbuf[(size_t)j * CONVD + ch];
#pragma unroll
        for (int j = 0; j < 8; ++j) up[3 + j] = __uint_as_float((unsigned)XBC[(size_t)(R0 + j) * CONVD + ch] << 16);
        const float w0 = cw[ch], w1 = cw[CONVD + ch], w2 = cw[2 * CONVD + ch], w3 = cw[3 * CONVD + ch], bs = cbias[ch];
#pragma unroll
        for (int t = 0; t < 8; ++t) xs[t] = silu_f(w0 * up[t] + w1 * up[t + 1] + w2 * up[t + 2] + w3 * up[t + 3] + bs);
        const float A = -__expf(P.in[I_ALOG][h]); const float db = P.in[I_DTB][h];
        float run = 0.f;
#pragma unroll
        for (int t = 0; t < 8; ++t) { dtv[t] = softplus_f(DT[(size_t)(R0 + t) * 64 + h] + db); run += dtv[t] * A; ac[t] = run; }
    }
    {
        float v[8];
#pragma unroll
        for (int s = 0; s < 8; ++s) v[s] = __expf(ac[7] - ac[s]) * dtv[s] * xs[s];
        *(u32x4*)(xw16 + lane * 8) = pack8(v);
    }
    LDS_BARRIER();
    {
        const int s = lane & 7, part = lane >> 3;
        float d = 0.f;
#pragma unroll
        for (int n = 0; n < 16; ++n) d += Csm[wid * 128 + part * 16 + n] * Bsm[s * 128 + part * 16 + n];
        d += __shfl_xor(d, 8); d += __shfl_xor(d, 16); d += __shfl_xor(d, 32);
        if (lane < 8) cbs[wid * 8 + lane] = d;
    }
    {
        const float ee = __expf(ac[7]);
        const bf16x8 zero8 = (bf16x8){0, 0, 0, 0, 0, 0, 0, 0};
        bf16x8 cfrag[4], btf[8];
#pragma unroll
        for (int kk = 0; kk < 4; ++kk) cfrag[kk] = (fr < 8) ? *(const bf16x8*)(C16 + fr * 128 + 32 * kk + 8 * fq) : zero8;
#pragma unroll
        for (int nt = 0; nt < 8; ++nt) btf[nt] = (fq == 0) ? *(const bf16x8*)(BT16 + (16 * nt + fr) * 8) : zero8;
#pragma unroll
        for (int j = 0; j < 4; ++j) {
            const float* hp = st_in + (size_t)(16 * j + fr) * 128;
            f32x4 hb[4][2], hc[8];
#pragma unroll
            for (int kk = 0; kk < 4; ++kk) { hb[kk][0] = *(const f32x4*)(hp + 32 * kk + 8 * fq); hb[kk][1] = *(const f32x4*)(hp + 32 * kk + 8 * fq + 4); }
#pragma unroll
            for (int nt = 0; nt < 8; ++nt) hc[nt] = *(const f32x4*)(hp + 16 * nt + 4 * fq);
            f32x4 ya = (f32x4){0.f, 0.f, 0.f, 0.f};
#pragma unroll
            for (int kk = 0; kk < 4; ++kk) {
                u32x4 hw; hw.x = pk2(hb[kk][0][0], hb[kk][0][1]); hw.y = pk2(hb[kk][0][2], hb[kk][0][3]); hw.z = pk2(hb[kk][1][0], hb[kk][1][1]); hw.w = pk2(hb[kk][1][2], hb[kk][1][3]);
                ya = __builtin_amdgcn_mfma_f32_16x16x32_bf16(cfrag[kk], *(const bf16x8*)&hw, ya, 0, 0, 0);
            }
            if (fq < 2) {
#pragma unroll
                for (int jj = 0; jj < 4; ++jj) yis[(4 * fq + jj) * 64 + 16 * j + fr] = ya[jj];
            }
            const bf16x8 xf = (fq == 0) ? *(const bf16x8*)(xw16 + (16 * j + fr) * 8) : zero8;
            float* op = st_out + (size_t)(16 * j + fr) * 128;
#pragma unroll
            for (int nt = 0; nt < 8; ++nt) {
                const f32x4 d = __builtin_amdgcn_mfma_f32_16x16x32_bf16(btf[nt], xf, hc[nt] * ee, 0, 0, 0);
                *(f32x4*)(op + 16 * nt + 4 * fq) = d;
            }
        }
    }
    LDS_BARRIER();
#pragma unroll
    for (int t = 0; t < 8; ++t) {
        float a = 0.f;
#pragma unroll
        for (int s = 0; s <= t; ++s) a += cbs[t * 8 + s] * __expf(ac[t] - ac[s]) * dtv[s] * xs[s];
        const float y = a + P.in[I_SSDD][h] * xs[t] + __expf(ac[t]) * yis[t * 64 + lane];
        Y[(size_t)(R0 + t) * DIN + h * 64 + lane] = (bf16_t)(pk2(y, 0.f) & 0xffffu);
    }
}

__device__ __forceinline__ void ssd_scan_item(const Params& P, int item, unsigned char* smem) {
    const int tid = opq(threadIdx.x), lane = tid & 63, wid = tid >> 6, fr = lane & 15, fq = lane >> 4;
    const int b = item >> 6, h = item & 63, g = h >> 3;
    unsigned char* ws = opqp(P.ws);
    const bf16_t* CC = (const bf16_t*)(ws + O_CC); const bf16_t* XS = (const bf16_t*)(ws + O_XS); bf16_t* Y = (bf16_t*)(ws + O_Y);
    const float* SC = (const float*)(ws + O_SC); const float* ACUM = (const float*)(ws + O_ACUM);
    bf16_t* Cs = (bf16_t*)smem; bf16_t* Hs = (bf16_t*)(smem + 34816); float* acs = (float*)(smem + 34816 + 17408);
    const int n4 = (tid & 31) * 4, pb = tid >> 5;
    const int t = 16 * wid + fr;
    f32x4 st[4];
#pragma unroll
    for (int i = 0; i < 4; ++i) st[i] = (f32x4){0.f, 0.f, 0.f, 0.f};
    u32x4 cpf[4]; float acv = 0.f; u32x2 ywn[4]; u32x2 scn[4];
#define SCAN_PREFETCH(cn) do { const int _row0 = b * 2048 + (cn) * 128; \
        _Pragma("unroll") for (int i = 0; i < 4; ++i) { const int piece = tid + 512 * i, r = piece >> 4, q = piece & 15; cpf[i] = *(const u32x4*)(CC + (size_t)(_row0 + r) * 1024 + g * 128 + q * 8); } \
        if (tid < 128) acv = ACUM[((size_t)(b * 64 + h)) * 2048 + (cn) * 128 + tid]; \
        _Pragma("unroll") for (int j = 0; j < 4; ++j) { const size_t idx = (size_t)(_row0 + t) * DIN + h * 64 + 16 * j + 4 * fq; ywn[j] = *(const u32x2*)(Y + idx); } \
        { const bf16_t* scb = (const bf16_t*)SC + ((size_t)((b * 16 + (cn)) * 64 + h)) * 64 * 128; \
          _Pragma("unroll") for (int i = 0; i < 4; ++i) scn[i] = *(const u32x2*)(scb + (size_t)(pb + 16 * i) * 128 + n4); } } while (0)
    SCAN_PREFETCH(0);
    LDS_BARRIER();
#pragma unroll 1
    for (int c = 0; c < 16; ++c) {
        const int row0 = b * 2048 + c * 128;
#pragma unroll
        for (int i = 0; i < 4; ++i) { const int piece = tid + 512 * i, r = piece >> 4, q = piece & 15; *(u32x4*)(Cs + r * LST + q * 8) = cpf[i]; }
        if (tid < 128) acs[tid] = acv;
#pragma unroll
        for (int i = 0; i < 4; ++i) { u32x2 w2; w2.x = pk2(st[i][0], st[i][1]); w2.y = pk2(st[i][2], st[i][3]); *(u32x2*)(Hs + (pb + 16 * i) * LST + n4) = w2; }
        u32x2 yw[4]; u32x2 scv[4];
#pragma unroll
        for (int j = 0; j < 4; ++j) { yw[j] = ywn[j]; scv[j] = scn[j]; }
        LDS_BARRIER();
        if (c < 15) SCAN_PREFETCH(c + 1);
        {
            f32x4 acc[4];
#pragma unroll
            for (int j = 0; j < 4; ++j) acc[j] = (f32x4){0.f, 0.f, 0.f, 0.f};
#pragma unroll
            for (int kk = 0; kk < 4; ++kk) {
                const bf16x8 a = lds_frag(Cs, 16 * wid + fr, 32 * kk + 8 * fq);
#pragma unroll
                for (int j = 0; j < 4; ++j) { const bf16x8 bb = lds_frag(Hs, 16 * j + fr, 32 * kk + 8 * fq); acc[j] = __builtin_amdgcn_mfma_f32_16x16x32_bf16(bb, a, acc[j], 0, 0, 0); }
            }
            const float et = __expf(acs[t]);
#pragma unroll
            for (int j = 0; j < 4; ++j) {
                const size_t idx = (size_t)(row0 + t) * DIN + h * 64 + 16 * j + 4 * fq;
                const float y0 = bflo(yw[j].x) + et * acc[j][0], y1 = bfhi(yw[j].x) + et * acc[j][1];
                const float y2 = bflo(yw[j].y) + et * acc[j][2], y3 = bfhi(yw[j].y) + et * acc[j][3];
                u32x2 o; o.x = pk2(y0, y1); o.y = pk2(y2, y3); *(u32x2*)(Y + idx) = o;
            }
        }
        {
            const float ec = __expf(acs[127]);
#pragma unroll
            for (int i = 0; i < 4; ++i) st[i] = st[i] * ec + (f32x4){bflo(scv[i].x), bfhi(scv[i].x), bflo(scv[i].y), bfhi(scv[i].y)};
        }
        LDS_BARRIER();
    }
#undef SCAN_PREFETCH
    float* so = P.out + OO_SSDP + ((size_t)(b * 64 + h)) * 64 * 128;
#pragma unroll
    for (int i = 0; i < 4; ++i) *(f32x4*)(so + (size_t)(pb + 16 * i) * 128 + n4) = st[i];
}

__device__ __forceinline__ void ssd_gate_phase(const Params& P) {
    unsigned char* ws = opqp(P.ws); const bf16_t* Y = (const bf16_t*)(ws + O_Y); const bf16_t* Z = (const bf16_t*)(ws + O_Z); bf16_t* A7 = (bf16_t*)(ws + O_A7);
    const float* ng = P.in[I_NORMG];
    const int tidq = opq(threadIdx.x); const int lane = tidq & 63, gw = blockIdx.x * 8 + (tidq >> 6), NGW = 2048;
    for (int it = gw; it < NTOK * 8; it += NGW) {
        const int r = it >> 3, g = it & 7; const size_t idx = (size_t)r * DIN + g * 512 + lane * 8;
        float y[8], z[8], gt[8]; unpack8(*(const u32x4*)(Y + idx), y); unpack8(*(const u32x4*)(Z + idx), z);
        float s = 0.f;
#pragma unroll
        for (int e = 0; e < 8; ++e) { gt[e] = y[e] * silu_f(z[e]); s += gt[e] * gt[e]; }
        s = wave_sum(s);
        const float sc = rsqrtf(s * (1.f / 512.f) + EPSN);
        float gn[8]; *(f32x4*)(gn) = *(const f32x4*)(ng + g * 512 + lane * 8); *(f32x4*)(gn + 4) = *(const f32x4*)(ng + g * 512 + lane * 8 + 4);
#pragma unroll
        for (int e = 0; e < 8; ++e) gt[e] = gt[e] * sc * gn[e];
        *(u32x4*)(A7 + idx) = pack8(gt);
    }
}

__device__ __forceinline__ void final_phase(const Params& P) {
    unsigned char* ws = opqp(P.ws); const float* H = (const float*)(ws + O_H); const float* SS = (const float*)(ws + O_SS) + 6 * NTOK; const float* gf = P.in[I_GFIN];
    const int tidq = opq(threadIdx.x); const int lane = tidq & 63, gw = blockIdx.x * 8 + (tidq >> 6), NGW = 2048;
    for (int r = gw; r < NTOK; r += NGW) {
        const float rs = rstd_of(SS, r);
#pragma unroll
        for (int j = 0; j < 8; ++j) { const int c = (j * 64 + lane) * 4; const f32x4 v = *(const f32x4*)(H + (size_t)r * DM + c); const f32x4 gv = *(const f32x4*)(gf + c);
            *(f32x4*)(P.out + OO_Y + (size_t)r * DM + c) = v * rs * gv; }
    }
}

__global__ void __launch_bounds__(512, 2) hybrid_mega(Params P) {
    extern __shared__ __attribute__((aligned(16))) unsigned char smem[];
    cg::grid_group grid = cg::this_grid();
    LAS unsigned char* lds = (LAS unsigned char*)smem;
    unsigned char* ws = opqp(P.ws);
    float* SS = (float*)(ws + O_SS); float* H = (float*)(ws + O_H);
    bf16_t* HB0 = (bf16_t*)(ws + O_HB); bf16_t* HB1 = (bf16_t*)(ws + O_PP);
    constexpr int G = 256;
    const int c = (int)blockIdx.x;
    pg8::StaticOrder S;

    unsigned* bar = (unsigned*)(ws + O_BAR); volatile LAS unsigned* bst = (volatile LAS unsigned*)(lds + LDS_BAR_OFF);
    xcd_barrier_post(bar, bst);
    phase0(P, smem);
    if (P.out == nullptr) grid.sync();
    xcd_barrier(bar, bst);
#pragma unroll 1
    for (int l = 0; l < 2; ++l) {
        pg8::Gemm gm;
        bf16_t* HB = l ? HB1 : HB0; bf16_t* HBn = l ? (bf16_t*)nullptr : HB1;
        if (l == 0) {
            constexpr int gs1 = 216;
            {
                pg8::Gemm g1{HB, (const bf16_t*)(ws + O_W1), NTOK, 6144, 2048};
                EpiScIn e{SS, (bf16_t*)(ws + O_BG), (bf16_t*)(ws + O_U), P.out + OO_SCP, P.out + OO_SCS};
                if (c < gs1) { S.init(g1.M, g1.N, gs1, opqs(c)); pg8::gemm_phase(lds, g1, S, e); }
            }
            if (c >= gs1)
#pragma unroll 1
            for (int l2 = 0; l2 < 2; ++l2) {
                pg8::Gemm gp{(const bf16_t*)(ws + O_PB) + (size_t)l2 * NTOK * 256, (const bf16_t*)(ws + O_WP + l2 * SZ_WP), NTOK, 2048, 256};
                EpiPlain e{(bf16_t*)(ws + O_PP) + (size_t)l2 * NTOK * DM};
                S.init(gp.M, gp.N, G - gs1, opqs(c) - gs1); pg8::gemm_phase(lds, gp, S, e);
            }
            xcd_barrier(bar, bst);
            sc_conv_phase(P);
            xcd_barrier(bar, bst);
            gm = pg8::Gemm{(const bf16_t*)(ws + O_BG), (const bf16_t*)(ws + O_W2), NPR, 2048, 2048};
        } else {
            {
                pg8::Gemm g6{HB, (const bf16_t*)(ws + O_W6), NTOK, NSSDP, 2048};
                EpiSsdIn e{SS + 3 * NTOK, (bf16_t*)(ws + O_Z), (bf16_t*)(ws + O_XBC), (float*)(ws + O_DT), P.out + OO_SSDCP, P.out + OO_SSDCS};
                if (c < 246) { S.init(g6.M, g6.N, 246, opqs(c)); pg8::gemm_phase(lds, g6, S, e); }
                else cvt_jobs(P, smem, 1u << 12, (c - 246) * 8 + (opq(threadIdx.x) >> 6), 10 * 8);
            }
            xcd_barrier(bar, bst);
            for (int it = c; it < 512 + 1024; it += G) { if (it < 512) ssd_prompt_item(P, it, smem); else ssd_sample_item(P, it - 512, smem); }
            xcd_barrier(bar, bst);
            for (int it = c; it < 256; it += G) ssd_scan_item(P, it, smem);
            xcd_barrier(bar, bst);
            ssd_gate_phase(P);
            xcd_barrier(bar, bst);
            gm = pg8::Gemm{(const bf16_t*)(ws + O_A7), (const bf16_t*)(ws + O_W7), NPR, 2048, 4096};
        }
        float* ss_l = SS + 3 * l * NTOK;
        {
            const float* hin_main = l ? (const float*)H : P.in[I_XP];
            const float* hin_small = l ? (const float*)H : P.in[I_XS] - (size_t)NPR * DM;
            EpiRes<0> e{H, HB, ss_l + NTOK, nullptr, nullptr, hin_main};
            S.init(gm.M, gm.N, G, opqs(c)); pg8::gemm_phase(lds, gm, S, e);
            for (int u = c; u < 256; u += G) small_gemm_res<0>(smem, gm.A + (size_t)NPR * gm.K, gm.Bt, gm.K, H, hin_small, HB, ss_l + NTOK, nullptr, nullptr, u);
        }
        xcd_barrier(bar, bst);
        {
            pg8::Gemm g3{HB, (const bf16_t*)(ws + O_W3 + l * SZ_W3), NTOK, 11264, 2048};
            EpiGateUp e{ss_l + NTOK, (bf16_t*)(ws + O_ACT)};
            constexpr int gg = 228;
            if (c < gg) { S.init(g3.M, g3.N, gg, opqs(c)); pg8::gemm_phase(lds, g3, S, e); }
            else cvt_jobs(P, smem, l == 0 ? ((1u << 5) | (1u << 7) | (1u << 11) | (1u << 4)) : ((1u << 6) | (1u << 8)), (c - gg) * 8 + (opq(threadIdx.x) >> 6), (G - gg) * 8);
        }
        xcd_barrier(bar, bst);
        {
            pg8::Gemm g4{(const bf16_t*)(ws + O_ACT), (const bf16_t*)(ws + O_W4 + l * SZ_W4), NPR, 2048, DFF};
            EpiRes<0> e{H, HB, ss_l + 2 * NTOK, nullptr, nullptr, H};
            S.init(g4.M, g4.N, G, opqs(c)); pg8::gemm_phase(lds, g4, S, e);
            for (int u = c; u < 256; u += G) small_gemm_res<0>(smem, g4.A + (size_t)NPR * g4.K, g4.Bt, g4.K, H, H, HB, ss_l + 2 * NTOK, nullptr, nullptr, u);
        }
        xcd_barrier(bar, bst);
        {
            pg8::Gemm g5{HB, (const bf16_t*)(ws + O_W5 + l * SZ_W5), NPR, 2048, 2048};
            EpiRes<1> e{H, HBn, ss_l + 3 * NTOK, ss_l + 2 * NTOK, (const bf16_t*)(ws + O_PP) + (size_t)l * NTOK * DM, H};
            S.init(g5.M, g5.N, G, opqs(c)); pg8::gemm_phase(lds, g5, S, e);
            for (int u = c; u < 256; u += G) small_gemm_res<1>(smem, g5.A + (size_t)NPR * g5.K, g5.Bt, g5.K, H, H, HBn, ss_l + 3 * NTOK, ss_l + 2 * NTOK, e.PPl, u);
        }
        xcd_barrier(bar, bst);
    }
    final_phase(P);
}

extern "C" void kernel_launch(void* const* d_in, const int* in_sizes, int n_in, void* d_out, int out_size, void* d_ws, size_t ws_size, hipStream_t stream) {
    static int grid_blocks = 0;
    if (grid_blocks == 0) {
        if (n_in != 27 || ws_size < WS_END) { fprintf(stderr, "kernel_launch: need 27 inputs and %zu B workspace (got %d, %zu)\n", (size_t)WS_END, n_in, ws_size); grid_blocks = -1; return; }
        int dev = 0, cus = 0, per_cu = 0;
        hipGetDevice(&dev);
        hipDeviceGetAttribute(&cus, hipDeviceAttributeMultiprocessorCount, dev);
        if (hipFuncSetAttribute((const void*)hybrid_mega, hipFuncAttributeMaxDynamicSharedMemorySize, LDS_BYTES) != hipSuccess) { fprintf(stderr, "kernel_launch: hipFuncSetAttribute failed\n"); grid_blocks = -1; return; }
        if (hipOccupancyMaxActiveBlocksPerMultiprocessor(&per_cu, (const void*)hybrid_mega, 512, LDS_BYTES) != hipSuccess || per_cu < 1) { fprintf(stderr, "kernel_launch: occupancy query failed (%d)\n", per_cu); grid_blocks = -1; return; }
        if (cus < 256) { fprintf(stderr, "kernel_launch: built for a 256-CU device (got %d CUs)\n", cus); grid_blocks = -1; return; }
        grid_blocks = 256;
    }
    if (grid_blocks < 0) return;
    Params p; memset(&p, 0, sizeof(p));
    for (int i = 0; i < 27; ++i) p.in[i] = (const float*)d_in[i];
    p.out = (float*)d_out; p.ws = (unsigned char*)d_ws;
    (void)hipMemsetAsync((unsigned char*)d_ws + O_BAR, 0, BAR_BYTES, stream);
    void* args[] = {&p};
    hipError_t e = hipLaunchCooperativeKernel((const void*)hybrid_mega, dim3(grid_blocks), dim3(512), args, LDS_BYTES, stream);
    if (e != hipSuccess) fprintf(stderr, "cooperative launch failed: %s (grid %d)\n", hipGetErrorString(e), grid_blocks);
}
```

```cpp
#include <hip/hip_runtime.h>
#include <hip/hip_cooperative_groups.h>
#include <cstdio>
#include <cstring>
namespace cg = cooperative_groups;

#define LAS __attribute__((address_space(3)))
typedef unsigned short bf16_t;
typedef short bf16x8 __attribute__((ext_vector_type(8)));
typedef float f32x4 __attribute__((ext_vector_type(4)));
typedef float f32x2 __attribute__((ext_vector_type(2)));
typedef unsigned u32x4 __attribute__((ext_vector_type(4)));
typedef unsigned u32x2 __attribute__((ext_vector_type(2)));

constexpr int NTOK = 9216, NPR = 8192, DM = 2048, DFF = 5632, DIN = 4096, CONVD = 6144, NSSD = 10304, NSSDP = 10496;
constexpr float EPSN = 1e-6f;
constexpr int LDS_BYTES = 157696 + 16;
constexpr int LDS_BAR_OFF = 157696;

constexpr size_t SZ_W1 = 6144ull * 2048 * 2, SZ_W2 = 2048ull * 2048 * 2, SZ_W3 = 11264ull * 2048 * 2, SZ_W4 = 2048ull * 5632 * 2,
                 SZ_W5 = SZ_W2, SZ_WP = 2048ull * 256 * 2, SZ_W6 = (size_t)NSSDP * 2048 * 2, SZ_W7 = 2048ull * 4096 * 2;
constexpr size_t O_W1 = 0, O_W2 = O_W1 + SZ_W1, O_W3 = O_W2 + SZ_W2, O_W4 = O_W3 + 2 * SZ_W3, O_W5 = O_W4 + 2 * SZ_W4, O_WP = O_W5 + 2 * SZ_W5,
                 O_W6 = O_WP + 2 * SZ_WP, O_W7 = O_W6 + SZ_W6;
constexpr size_t O_H = O_W7 + SZ_W7;
constexpr size_t O_HB = O_H + (size_t)NTOK * DM * 4;
constexpr size_t O_BG = O_HB + (size_t)NTOK * DM * 2;
constexpr size_t O_U = O_BG + (size_t)NTOK * DM * 2;
constexpr size_t O_XS = O_BG;
constexpr size_t O_ACT = O_U + (size_t)NTOK * DM * 2;
constexpr size_t O_A7 = O_ACT;
constexpr size_t O_PB = O_ACT + (size_t)NTOK * DFF * 2;
constexpr size_t O_PP = O_PB + 2ull * NTOK * 256 * 2;
constexpr size_t O_Z = O_PP + 2ull * NTOK * DM * 2;
constexpr size_t O_XBC = O_Z + (size_t)NTOK * DIN * 2;
constexpr size_t O_DT = O_XBC + (size_t)NTOK * CONVD * 2;
constexpr size_t O_CC = O_DT + (size_t)NTOK * 64 * 4;
constexpr size_t O_Y = O_CC + (size_t)NPR * 1024 * 2;
constexpr size_t O_SC = O_Y + (size_t)NTOK * DIN * 2;
constexpr size_t O_ACUM = O_SC + 4ull * 16 * 64 * 64 * 128 * 4;
constexpr size_t O_SS = O_ACUM + 4ull * 64 * 2048 * 4;
constexpr size_t O_BAR = O_SS + 7ull * NTOK * 4;
constexpr size_t BAR_BYTES = 3456 * 4;
constexpr size_t WS_END = O_BAR + BAR_BYTES;
static_assert(WS_END <= (1ull << 30), "workspace too large");

constexpr size_t OO_Y = 0, OO_SCP = (size_t)NTOK * DM, OO_SCS = OO_SCP + 4 * 2 * 2048, OO_SSDCP = OO_SCS + 128 * 2 * 2048,
                 OO_SSDCS = OO_SSDCP + 4 * 3 * CONVD, OO_SSDP = OO_SSDCS + 128 * 3 * CONVD, OO_SSDS = OO_SSDP + 4ull * 64 * 64 * 128;

struct Params { const float* in[27]; float* out; unsigned char* ws; };
enum { I_XP = 0, I_XS, I_PP, I_PS, I_SSC, I_SSDC, I_SSD, I_GMIX, I_GFFN, I_GPLE, I_GFIN, I_SCWIN, I_SCWCONV, I_SCWOUT, I_SSDWIN, I_SSDCONVW, I_SSDCONVB,
       I_DTB, I_ALOG, I_SSDD, I_NORMG, I_SSDWOUT, I_WGATE, I_WUP, I_WDOWN, I_PLEPROJ, I_PLEGATE };

__device__ __forceinline__ unsigned pk2(float lo, float hi) { unsigned r; asm volatile("v_cvt_pk_bf16_f32 %0, %1, %2" : "=v"(r) : "v"(lo), "v"(hi)); return r; }
__device__ __forceinline__ float bflo(unsigned w) { return __uint_as_float(w << 16); }
__device__ __forceinline__ float bfhi(unsigned w) { return __uint_as_float(w & 0xffff0000u); }
__device__ __forceinline__ float wave_sum(float v) {
#pragma unroll
    for (int o = 1; o < 64; o <<= 1) v += __shfl_xor(v, o);
    return v;
}
__device__ __forceinline__ float silu_f(float x) { return x * __builtin_amdgcn_rcpf(1.f + __expf(-x)); }
__device__ __forceinline__ float sigmoid_f(float x) { return __builtin_amdgcn_rcpf(1.f + __expf(-x)); }
__device__ __forceinline__ float softplus_f(float x) { return x > 20.f ? x : log1pf(__expf(x)); }
__device__ __forceinline__ void unpack8(const u32x4 w, float (&f)[8]) {
    f[0] = bflo(w.x); f[1] = bfhi(w.x); f[2] = bflo(w.y); f[3] = bfhi(w.y); f[4] = bflo(w.z); f[5] = bfhi(w.z); f[6] = bflo(w.w); f[7] = bfhi(w.w);
}
__device__ __forceinline__ u32x4 pack8(const float (&f)[8]) { u32x4 w; w.x = pk2(f[0], f[1]); w.y = pk2(f[2], f[3]); w.z = pk2(f[4], f[5]); w.w = pk2(f[6], f[7]); return w; }
#define LDS_FENCE() asm volatile("s_waitcnt lgkmcnt(0)" ::: "memory")
#define LDS_BARRIER() do { asm volatile("s_waitcnt lgkmcnt(0)" ::: "memory"); __builtin_amdgcn_s_barrier(); asm volatile("" ::: "memory"); } while (0)
__device__ __forceinline__ int opq(int x) { asm volatile("" : "+v"(x)); return x; }
__device__ __forceinline__ int opqs(int x) { asm volatile("" : "+s"(x)); return x; }
template <class T> __device__ __forceinline__ T* opqp(T* p) { asm volatile("" : "+s"(p)); return p; }


#define XB_TMO      128
#define XB_XCNT(j)  (256  + 64 * (j))
#define XB_XSUB(j)  (1280 + 64 * (j))
#define XB_XGEN(j)  (2304 + 64 * (j))
#define XB_TOP      3328
#define XB_TOPGEN   3392
#define XB_SPIN_CAP (1u << 18)
__device__ __forceinline__ unsigned xb_ld(unsigned* p)              { return __hip_atomic_load(p, __ATOMIC_RELAXED, __HIP_MEMORY_SCOPE_AGENT); }
__device__ __forceinline__ unsigned xb_add(unsigned* p, unsigned v) { return __hip_atomic_fetch_add(p, v, __ATOMIC_RELAXED, __HIP_MEMORY_SCOPE_AGENT); }
__device__ __forceinline__ unsigned xb_xcc_id() { return (unsigned)__builtin_amdgcn_s_getreg((3 << 11) | 20) & 0xFu; }
#define XB_SPIN(cond, bar) do { unsigned _sp = 0; while (cond) { __builtin_amdgcn_s_sleep(1); \
    if ((++_sp & 255u) == 0u) { if (xb_ld(&(bar)[XB_TMO])) break; if (_sp > XB_SPIN_CAP) { atomicAdd(&(bar)[XB_TMO], 1u); break; } } } } while (0)
__device__ __forceinline__ void xcd_barrier_complete(unsigned* bar, unsigned x, unsigned& nloc, unsigned& nx) {
    const unsigned G = gridDim.x * gridDim.y * gridDim.z;
    unsigned sum, cnt, mine, sp = 0u;
    for (;;) {
        sum = 0u; cnt = 0u; mine = 0u;
#pragma unroll
        for (unsigned j = 0; j < 16; ++j) { const unsigned c = xb_ld(&bar[XB_XCNT(j)]); sum += c; cnt += (c > 0u) ? 1u : 0u; mine = (j == x) ? c : mine; }
        if (sum == G) break;
        __builtin_amdgcn_s_sleep(1);
        if ((++sp & 255u) == 0u) { if (xb_ld(&bar[XB_TMO])) break; if (sp > XB_SPIN_CAP) { atomicAdd(&bar[XB_TMO], 1u); break; } }
    }
    nloc = mine > 0u ? mine : 1u; nx = cnt > 0u ? cnt : 1u;
}
__device__ __forceinline__ void xcd_barrier_post(unsigned* bar, volatile LAS unsigned* st) {
    if (threadIdx.x == 0) { st[0] = 0u; st[1] = 0u; (void)xb_add(&bar[XB_XCNT(xb_xcc_id())], 1u); }
    __syncthreads();
}
__device__ __forceinline__ void xcd_barrier(unsigned* bar, volatile LAS unsigned* st) {
    asm volatile("s_waitcnt vmcnt(0)" ::: "memory");
    __syncthreads();
    if (threadIdx.x == 0) {
        __builtin_amdgcn_s_waitcnt(0);
        const unsigned x = xb_xcc_id();
        unsigned nloc = st[0], nx = st[1];
        if (nloc == 0u) { xcd_barrier_complete(bar, x, nloc, nx); st[0] = nloc; st[1] = nx; }
        const unsigned old = xb_add(&bar[XB_XSUB(x)], 1u);
        const unsigned gen = old / nloc;
        if (old + 1u == (gen + 1u) * nloc) {
            __builtin_amdgcn_fence(__ATOMIC_RELEASE, "agent");
            asm volatile("s_waitcnt vmcnt(0)" ::: "memory");
            const unsigned og = xb_add(&bar[XB_TOP], 1u);
            const unsigned tg = og / nx;
            if (og + 1u == (tg + 1u) * nx) xb_add(&bar[XB_TOPGEN], 1u);
            else XB_SPIN(xb_ld(&bar[XB_TOPGEN]) == tg, bar);
            __builtin_amdgcn_fence(__ATOMIC_ACQUIRE, "agent");
            xb_add(&bar[XB_XGEN(x)], 1u);
            asm volatile("s_waitcnt vmcnt(0)" ::: "memory");
        } else {
            XB_SPIN(xb_ld(&bar[XB_XGEN(x)]) == gen, bar);
            __builtin_amdgcn_fence(__ATOMIC_ACQUIRE, "agent");
            asm volatile("s_waitcnt vmcnt(0)" ::: "memory");
        }
    }
    __syncthreads();
}

namespace pg8 {
constexpr int BM = 256, BK = 64, HALF = 128, HTB = HALF * BK * 2, STAGE_BYTES = 8 * HTB, NXCD = 8, WGM = 8;
__device__ __forceinline__ int lds_byte(int r, int c) { const int st = (r >> 4) * 2 + (c >> 5), rr = r & 15, cc = c & 31, ob = rr * 64 + cc * 2; return st * 1024 + (ob ^ (((ob >> 9) & 1) << 5)); }
__device__ __forceinline__ void stage_rc(int b, int& R, int& C) { const int st = b / 1024, sb = b % 1024, swz = sb ^ (((sb >> 9) & 1) << 5); R = (st >> 1) * 16 + swz / 64; C = (st & 1) * 32 + (swz % 64) / 2; }
__device__ __forceinline__ int perm32(int rho) { const int n = rho >> 4, i = rho & 15; return 8 * (i >> 2) + 4 * n + (i & 3); }
struct Unit { int pm, pn; };
struct Gemm { const bf16_t* A; const bf16_t* Bt; int M, N, K; };
struct StaticOrder {
    int nM, nN, nwg, G, c;
    __device__ void init(int M, int N, int G_, int c_) { nM = M / BM; nN = N / BM; nwg = nM * nN; G = G_; c = c_; }
    __device__ bool next(int i, Unit& u) const {
        const long L = (long)i * G + c; if (L >= nwg) return false;
        int wgid = (int)L; { const int q = nwg / NXCD, r = nwg % NXCD, xcd = wgid % NXCD, off = wgid / NXCD; wgid = (xcd < r ? xcd * (q + 1) : r * (q + 1) + (xcd - r) * q) + off; }
        const int nig = WGM * nN, gid = wgid / nig, fm = gid * WGM, gsz = (nM - fm) < WGM ? (nM - fm) : WGM;
        u.pm = fm + ((wgid % nig) % gsz); u.pn = (wgid % nig) / gsz; return true;
    }
};

template <class Epi>
__device__ __forceinline__ void gemm_phase(LAS unsigned char* lds, const Gemm g, const StaticOrder& S, const Epi& E) {
    const int tid = opq(threadIdx.x), wid = __builtin_amdgcn_readfirstlane(tid >> 6), lane = tid & 63, wr = wid >> 2, wc = wid & 3, fr = lane & 15, fq = lane >> 4;
    const int K = g.K, nt = K / BK;
    unsigned voffA[2], voffB[2];
#pragma unroll
    for (int i = 0; i < 2; ++i) { int R, C; stage_rc(tid * 16 + i * 8192, R, C); const int Rb = (R & ~31) + perm32(R & 31);
        voffA[i] = (unsigned)(R * K + C) * 2u; voffB[i] = (unsigned)(Rb * K + C) * 2u; }
    const size_t kstep = (size_t)(BK * 2);
    const size_t hstep = (size_t)HALF * K * 2;
    const size_t tstep = 2 * hstep;
    const unsigned ldsw = (unsigned)wid * 1024u;
    const int aoff = lds_byte(wr * 64 + fr, fq * 8), boff = lds_byte(wc * 32 + fr, fq * 8);
#define PG8_SA(b, h) (((b) * 2 + (h)) * HTB)
#define PG8_SB(b, h) ((4 + (b) * 2 + (h)) * HTB)
#define PG8_STAGE(bufoff, gbase, voff) do { _Pragma("unroll") for (int _i = 0; _i < 2; ++_i) \
        __builtin_amdgcn_global_load_lds((const unsigned*)((const char*)(gbase) + (voff)[_i]), (LAS unsigned*)(lds + (bufoff) + ldsw + _i * 8192), 16, 0, 0); } while (0)
#define PG8_LDA(dst, b, h) do { _Pragma("unroll") for (int m = 0; m < 4; ++m) _Pragma("unroll") for (int k = 0; k < 2; ++k) dst[m][k] = *(const LAS bf16x8*)(lds + PG8_SA(b, h) + aoff + m * 2048 + k * 1024); } while (0)
#define PG8_LDB(dst, b, h) do { _Pragma("unroll") for (int n = 0; n < 2; ++n) _Pragma("unroll") for (int k = 0; k < 2; ++k) dst[n][k] = *(const LAS bf16x8*)(lds + PG8_SB(b, h) + boff + n * 2048 + k * 1024); } while (0)
#define PG8_MMA(ai, bj, At, Bt) do { __builtin_amdgcn_s_setprio(1); _Pragma("unroll") for (int m = 0; m < 4; ++m) _Pragma("unroll") for (int n = 0; n < 2; ++n) _Pragma("unroll") for (int k = 0; k < 2; ++k) \
        acc[ai][bj][m][n] = __builtin_amdgcn_mfma_f32_16x16x32_bf16(Bt[n][k], At[m][k], acc[ai][bj][m][n], 0, 0, 0); __builtin_amdgcn_s_setprio(0); } while (0)
#define PG8_WAIT_V(n) asm volatile("s_waitcnt vmcnt(" #n ")" ::: "memory")
#define PG8_WAIT_L(n) asm volatile("s_waitcnt lgkmcnt(" #n ")" ::: "memory")
#define PG8_BAR __builtin_amdgcn_s_barrier()
#define PG8_SCHED __builtin_amdgcn_sched_barrier(0)
    Unit cur, nxt; int ui = 0;
    if (!S.next(0, cur)) return;
    f32x4 acc[2][2][4][2];
#pragma unroll
    for (int a = 0; a < 2; ++a)
#pragma unroll
        for (int b = 0; b < 2; ++b)
#pragma unroll
            for (int m = 0; m < 4; ++m)
#pragma unroll
                for (int n = 0; n < 2; ++n) acc[a][b][m][n] = (f32x4){0.f, 0.f, 0.f, 0.f};
    bf16x8 At[4][2], B0[2][2], B1[2][2];
    const char* cA = (const char*)g.A + (size_t)cur.pm * tstep; const char* cB = (const char*)g.Bt + (size_t)cur.pn * tstep;
    PG8_STAGE(PG8_SB(0, 0), cB, voffB); PG8_STAGE(PG8_SA(0, 0), cA, voffA); PG8_STAGE(PG8_SB(0, 1), cB + hstep, voffB); PG8_STAGE(PG8_SA(0, 1), cA + hstep, voffA);
    if (wr == 1) PG8_BAR;
    PG8_WAIT_V(4); PG8_BAR;
    PG8_STAGE(PG8_SB(1, 0), cB + kstep, voffB); PG8_STAGE(PG8_SA(1, 0), cA + kstep, voffA); PG8_STAGE(PG8_SB(1, 1), cB + hstep + kstep, voffB);
    PG8_WAIT_V(6); PG8_BAR;
    for (;;) {
        const bool has_next = S.next(ui + 1, nxt);
        const char* nA = has_next ? (const char*)g.A + (size_t)nxt.pm * tstep : cA; const char* nB = has_next ? (const char*)g.Bt + (size_t)nxt.pn * tstep : cB;
        for (int t = 0; t < nt; t += 2) {
            const bool last = (t == nt - 2);
            const char* a1 = cA + (size_t)(t + 1) * kstep;
            const char* a2 = last ? nA : cA + (size_t)(t + 2) * kstep; const char* b2 = last ? nB : cB + (size_t)(t + 2) * kstep;
            const char* a3 = a2 + kstep; const char* b3 = b2 + kstep;
            PG8_LDB(B0, 0, 0); PG8_SCHED; PG8_LDA(At, 0, 0); PG8_STAGE(PG8_SA(1, 1), a1 + hstep, voffA);
            PG8_WAIT_L(8); PG8_BAR; PG8_WAIT_L(0); PG8_MMA(0, 0, At, B0); PG8_BAR; PG8_SCHED;
            PG8_LDB(B1, 0, 1); PG8_STAGE(PG8_SB(0, 0), b2, voffB);
            PG8_BAR; PG8_WAIT_L(0); PG8_MMA(0, 1, At, B1); PG8_BAR;
            PG8_LDA(At, 0, 1); PG8_STAGE(PG8_SA(0, 0), a2, voffA);
            PG8_BAR; PG8_WAIT_L(0); PG8_MMA(1, 0, At, B0); PG8_BAR; PG8_SCHED;
            PG8_STAGE(PG8_SB(0, 1), b2 + hstep, voffB);
            PG8_WAIT_V(6); PG8_BAR; PG8_MMA(1, 1, At, B1); PG8_BAR;
            PG8_LDB(B0, 1, 0); PG8_SCHED; PG8_LDA(At, 1, 0); PG8_STAGE(PG8_SA(0, 1), a2 + hstep, voffA);
            PG8_WAIT_L(8); PG8_BAR; PG8_WAIT_L(0); PG8_MMA(0, 0, At, B0); PG8_BAR; PG8_SCHED;
            PG8_LDB(B1, 1, 1); PG8_STAGE(PG8_SB(1, 0), b3, voffB);
            PG8_BAR; PG8_WAIT_L(0); PG8_MMA(0, 1, At, B1); PG8_BAR;
            PG8_LDA(At, 1, 1); PG8_STAGE(PG8_SA(1, 0), a3, voffA);
            PG8_BAR; PG8_WAIT_L(0); PG8_MMA(1, 0, At, B0); PG8_BAR; PG8_SCHED;
            PG8_STAGE(PG8_SB(1, 1), b3 + hstep, voffB);
            PG8_WAIT_V(6); PG8_BAR; PG8_MMA(1, 1, At, B1); PG8_BAR;
        }
        E(acc, cur, wr, wc, fr, fq);
        if (!has_next) break;
#pragma unroll
        for (int a = 0; a < 2; ++a)
#pragma unroll
            for (int b = 0; b < 2; ++b)
#pragma unroll
                for (int m = 0; m < 4; ++m)
#pragma unroll
                    for (int n = 0; n < 2; ++n) acc[a][b][m][n] = (f32x4){0.f, 0.f, 0.f, 0.f};
        cur = nxt; cA = nA; cB = nB; ++ui;
    }
    PG8_WAIT_V(0);
    if (wr == 0) PG8_BAR;
    PG8_BAR;
#undef PG8_SA
#undef PG8_SB
#undef PG8_STAGE
#undef PG8_LDA
#undef PG8_LDB
#undef PG8_MMA
#undef PG8_WAIT_V
#undef PG8_WAIT_L
#undef PG8_BAR
#undef PG8_SCHED
}
}
using pg8::Unit;
typedef f32x4 AccT[2][2][4][2];

__device__ __forceinline__ float rstd_of(const float* ss, int r) { return rsqrtf(ss[r] * (1.f / DM) + EPSN); }

struct EpiScIn {
    const float* ss; bf16_t* BG; bf16_t* U; float* out_scp; float* out_scs;
    __device__ __forceinline__ void operator()(const AccT& acc, const Unit& u, int wr, int wc, int fr, int fq) const {
#pragma unroll
        for (int ai = 0; ai < 2; ++ai)
#pragma unroll
            for (int m = 0; m < 4; ++m) {
                const int r = u.pm * 256 + ai * 128 + wr * 64 + m * 16 + fr;
                const float rs = rstd_of(ss, r);
                if (u.pn < 8) {
#pragma unroll
                    for (int bj = 0; bj < 2; ++bj) {
                        const int c = u.pn * 256 + bj * 128 + wc * 32 + 8 * fq;
                        const f32x4 v0 = acc[ai][bj][m][0] * rs, v1 = acc[ai][bj][m][1] * rs;
                        u32x4 w; w.x = pk2(v0[0], v0[1]); w.y = pk2(v0[2], v0[3]); w.z = pk2(v1[0], v1[1]); w.w = pk2(v1[2], v1[3]);
                        *(u32x4*)(BG + (size_t)r * DM + c) = w;
                    }
                } else {
                    const int ch = (u.pn - 8) * 128 + wc * 32 + 8 * fq;
                    const float rs2 = rs * rs;
                    const f32x4 v0 = acc[ai][0][m][0] * acc[ai][1][m][0] * rs2, v1 = acc[ai][0][m][1] * acc[ai][1][m][1] * rs2;
                    u32x4 w; w.x = pk2(v0[0], v0[1]); w.y = pk2(v0[2], v0[3]); w.z = pk2(v1[0], v1[1]); w.w = pk2(v1[2], v1[3]);
                    *(u32x4*)(U + (size_t)r * DM + ch) = w;
                    float* o = nullptr;
                    if (r < NPR) { const int t = r & 2047; if (t >= 2046) o = out_scp + ((size_t)((r >> 11) * 2 + (t - 2046))) * DM + ch; }
                    else { const int rr = r - NPR, t = rr & 7; if (t >= 6) o = out_scs + ((size_t)((rr >> 3) * 2 + (t - 6))) * DM + ch; }
                    if (o) { *(f32x4*)o = v0; *(f32x4*)(o + 4) = v1; }
                }
            }
    }
};
struct EpiPlain {
    bf16_t* O;
    __device__ __forceinline__ void operator()(const AccT& acc, const Unit& u, int wr, int wc, int fr, int fq) const {
#pragma unroll
        for (int ai = 0; ai < 2; ++ai)
#pragma unroll
            for (int m = 0; m < 4; ++m) {
                const int r = u.pm * 256 + ai * 128 + wr * 64 + m * 16 + fr;
#pragma unroll
                for (int bj = 0; bj < 2; ++bj) {
                    const int c = u.pn * 256 + bj * 128 + wc * 32 + 8 * fq;
                    const f32x4 v0 = acc[ai][bj][m][0], v1 = acc[ai][bj][m][1];
                    u32x4 w; w.x = pk2(v0[0], v0[1]); w.y = pk2(v0[2], v0[3]); w.z = pk2(v1[0], v1[1]); w.w = pk2(v1[2], v1[3]);
                    *(u32x4*)(O + (size_t)r * DM + c) = w;
                }
            }
    }
};
template <int MODE> struct EpiRes {
    float* H; bf16_t* HB; float* ss_out; const float* ss_in; const bf16_t* PPl; const float* Hin;
    __device__ __forceinline__ void operator()(const AccT& acc, const Unit& u, int wr, int wc, int fr, int fq) const {
#pragma unroll
        for (int ai = 0; ai < 2; ++ai)
#pragma unroll
            for (int m = 0; m < 4; ++m) {
                const int r = u.pm * 256 + ai * 128 + wr * 64 + m * 16 + fr;
                float rs = 0.f; if (MODE == 1) rs = rstd_of(ss_in, r);
                float sq = 0.f;
#pragma unroll
                for (int bj = 0; bj < 2; ++bj) {
                    const int c = u.pn * 256 + bj * 128 + wc * 32 + 8 * fq;
                    float* hp = H + (size_t)r * DM + c; const float* hi = Hin + (size_t)r * DM + c;
                    f32x4 h0 = *(const f32x4*)hi, h1 = *(const f32x4*)(hi + 4);
                    f32x4 a0 = acc[ai][bj][m][0], a1 = acc[ai][bj][m][1];
                    if (MODE == 1) {
                        const u32x4 pw = *(const u32x4*)(PPl + (size_t)r * DM + c);
                        float pf[8]; unpack8(pw, pf);
#pragma unroll
                        for (int j = 0; j < 4; ++j) { a0[j] = pf[j] * sigmoid_f(a0[j] * rs); a1[j] = pf[4 + j] * sigmoid_f(a1[j] * rs); }
                    }
                    h0 += a0; h1 += a1;
                    *(f32x4*)hp = h0; *(f32x4*)(hp + 4) = h1;
                    u32x4 w; w.x = pk2(h0[0], h0[1]); w.y = pk2(h0[2], h0[3]); w.z = pk2(h1[0], h1[1]); w.w = pk2(h1[2], h1[3]);
                    *(u32x4*)(HB + (size_t)r * DM + c) = w;
                    sq += h0[0] * h0[0] + h0[1] * h0[1] + h0[2] * h0[2] + h0[3] * h0[3] + h1[0] * h1[0] + h1[1] * h1[1] + h1[2] * h1[2] + h1[3] * h1[3];
                }
                sq += __shfl_xor(sq, 16); sq += __shfl_xor(sq, 32);
                if (fq == 0) atomicAdd(ss_out + r, sq);
            }
    }
};
struct EpiGateUp {
    const float* ss; bf16_t* ACT;
    __device__ __forceinline__ void operator()(const AccT& acc, const Unit& u, int wr, int wc, int fr, int fq) const {
#pragma unroll
        for (int ai = 0; ai < 2; ++ai)
#pragma unroll
            for (int m = 0; m < 4; ++m) {
                const int r = u.pm * 256 + ai * 128 + wr * 64 + m * 16 + fr;
                const float rs = rstd_of(ss, r);
                const int ch = u.pn * 128 + wc * 32 + 8 * fq;
                float o[8];
#pragma unroll
                for (int n = 0; n < 2; ++n)
#pragma unroll
                    for (int j = 0; j < 4; ++j) { const float gv = acc[ai][0][m][n][j] * rs, uv = acc[ai][1][m][n][j] * rs; o[4 * n + j] = silu_f(gv) * uv; }
                *(u32x4*)(ACT + (size_t)r * DFF + ch) = pack8(o);
            }
    }
};
struct EpiSsdIn {
    const float* ss; bf16_t* Z; bf16_t* XBC; float* DT; float* out_cp; float* out_cs;
    __device__ __forceinline__ void operator()(const AccT& acc, const Unit& u, int wr, int wc, int fr, int fq) const {
#pragma unroll
        for (int ai = 0; ai < 2; ++ai)
#pragma unroll
            for (int m = 0; m < 4; ++m) {
                const int r = u.pm * 256 + ai * 128 + wr * 64 + m * 16 + fr;
                const float rs = rstd_of(ss, r);
#pragma unroll
                for (int bj = 0; bj < 2; ++bj) {
                    const int c = u.pn * 256 + bj * 128 + wc * 32 + 8 * fq;
                    const f32x4 v0 = acc[ai][bj][m][0] * rs, v1 = acc[ai][bj][m][1] * rs;
                    u32x4 w; w.x = pk2(v0[0], v0[1]); w.y = pk2(v0[2], v0[3]); w.z = pk2(v1[0], v1[1]); w.w = pk2(v1[2], v1[3]);
                    if (u.pn < 16) { *(u32x4*)(Z + (size_t)r * DIN + c) = w; }
                    else if (u.pn < 40) {
                        const int cc = c - DIN;
                        *(u32x4*)(XBC + (size_t)r * CONVD + cc) = w;
                        float* o = nullptr;
                        if (r < NPR) { const int t = r & 2047; if (t >= 2045) o = out_cp + ((size_t)((r >> 11) * 3 + (t - 2045))) * CONVD + cc; }
                        else { const int rr = r - NPR, t = rr & 7; if (t >= 5) o = out_cs + ((size_t)((rr >> 3) * 3 + (t - 5))) * CONVD + cc; }
                        if (o) { *(f32x4*)o = v0; *(f32x4*)(o + 4) = v1; }
                    } else {
                        const int cd = c - (DIN + CONVD);
                        if (cd < 64) { float* o = DT + (size_t)r * 64 + cd; *(f32x4*)o = v0; *(f32x4*)(o + 4) = v1; }
                    }
                }
            }
    }
};


template <int MODE>
__device__ __forceinline__ void small_gemm_res(unsigned char* smem, const bf16_t* A, const bf16_t* Bt, const int K, float* H, const float* Hin, bf16_t* HB, float* ss_out, const float* ss_in, const bf16_t* PPl, const int unit) {
    LAS unsigned char* lds = (LAS unsigned char*)smem;
    const int tid = opq(threadIdx.x), lane = tid & 63, wid = __builtin_amdgcn_readfirstlane(tid >> 6), fr = lane & 15, fq = lane >> 4, wm = wid >> 1, wn = wid & 1;
    const int row0 = (unit & 7) * 128, col0 = (unit >> 3) * 64;
    constexpr int NST = 5, STB = 24576;
    unsigned voffA[2], voffB;
#pragma unroll
    for (int i = 0; i < 2; ++i) { int R, C; pg8::stage_rc(tid * 16 + i * 8192, R, C); voffA[i] = (unsigned)(R * K + C) * 2u; if (i == 0) voffB = (unsigned)(R * K + C) * 2u; }
    const char* gA = (const char*)(A + (size_t)row0 * K); const char* gB = (const char*)(Bt + (size_t)col0 * K);
    const unsigned ldsw = (unsigned)wid * 1024u;
    const int aoff = pg8::lds_byte(wm * 32 + fr, fq * 8), boff = 16384 + pg8::lds_byte(wn * 32 + fr, fq * 8);
    f32x4 acc[2][2];
#pragma unroll
    for (int m = 0; m < 2; ++m)
#pragma unroll
        for (int n = 0; n < 2; ++n) acc[m][n] = (f32x4){0.f, 0.f, 0.f, 0.f};
    const int nt = K >> 6;
#define SG_STAGE(slotoff, t) do { const size_t _ko = (size_t)(t) * 128; \
        __builtin_amdgcn_global_load_lds((const unsigned*)(gA + voffA[0] + _ko), (LAS unsigned*)(lds + (slotoff) + ldsw), 16, 0, 0); \
        __builtin_amdgcn_global_load_lds((const unsigned*)(gA + voffA[1] + _ko), (LAS unsigned*)(lds + (slotoff) + ldsw + 8192), 16, 0, 0); \
        __builtin_amdgcn_global_load_lds((const unsigned*)(gB + voffB + _ko), (LAS unsigned*)(lds + (slotoff) + 16384 + ldsw), 16, 0, 0); } while (0)
    asm volatile("s_waitcnt vmcnt(0)" ::: "memory"); __builtin_amdgcn_s_barrier();
    SG_STAGE(0 * STB, 0); SG_STAGE(1 * STB, 1); SG_STAGE(2 * STB, 2); SG_STAGE(3 * STB, 3);
    int cs = 0, ns = 4 * STB;
#pragma unroll 1
    for (int t = 0; t < nt; ++t) {
        asm volatile("s_waitcnt vmcnt(9)" ::: "memory"); __builtin_amdgcn_s_barrier();
        { const int tn = (t + 4 < nt) ? t + 4 : nt - 1; SG_STAGE(ns, tn); }
#pragma unroll
        for (int kk = 0; kk < 2; ++kk) { bf16x8 af[2], bfr[2];
#pragma unroll
            for (int m = 0; m < 2; ++m) af[m] = *(const LAS bf16x8*)(lds + cs + aoff + m * 2048 + kk * 1024);
#pragma unroll
            for (int n = 0; n < 2; ++n) bfr[n] = *(const LAS bf16x8*)(lds + cs + boff + n * 2048 + kk * 1024);
#pragma unroll
            for (int m = 0; m < 2; ++m)
#pragma unroll
                for (int n = 0; n < 2; ++n) acc[m][n] = __builtin_amdgcn_mfma_f32_16x16x32_bf16(bfr[n], af[m], acc[m][n], 0, 0, 0); }
        cs += STB; if (cs == NST * STB) cs = 0;
        ns += STB; if (ns == NST * STB) ns = 0;
    }
    asm volatile("s_waitcnt vmcnt(0)" ::: "memory"); __builtin_amdgcn_s_barrier();
#undef SG_STAGE
#pragma unroll
    for (int m = 0; m < 2; ++m) {
        const int r = NPR + row0 + wm * 32 + m * 16 + fr;
        float rs = 0.f; if (MODE == 1) rs = rstd_of(ss_in, r);
        float sq = 0.f;
#pragma unroll
        for (int n = 0; n < 2; ++n) {
            const int c = col0 + wn * 32 + n * 16 + 4 * fq;
            float* hp = H + (size_t)r * DM + c;
            f32x4 h0 = *(const f32x4*)(Hin + (size_t)r * DM + c); f32x4 a = acc[m][n];
            if (MODE == 1) { const u32x2 pw = *(const u32x2*)(PPl + (size_t)r * DM + c);
                a[0] = bflo(pw.x) * sigmoid_f(a[0] * rs); a[1] = bfhi(pw.x) * sigmoid_f(a[1] * rs); a[2] = bflo(pw.y) * sigmoid_f(a[2] * rs); a[3] = bfhi(pw.y) * sigmoid_f(a[3] * rs); }
            h0 += a;
            *(f32x4*)hp = h0;
            u32x2 w; w.x = pk2(h0[0], h0[1]); w.y = pk2(h0[2], h0[3]); *(u32x2*)(HB + (size_t)r * DM + c) = w;
            sq += h0[0] * h0[0] + h0[1] * h0[1] + h0[2] * h0[2] + h0[3] * h0[3];
        }
        sq += __shfl_xor(sq, 16); sq += __shfl_xor(sq, 32);
        if (fq == 0) atomicAdd(ss_out + r, sq);
    }
}

struct CvtJob { const float* srcA; const float* srcB; const float* g; bf16_t* dst; int K, ld, nrows, nvalid, mode; };
__device__ __forceinline__ void cvt_item(const CvtJob& J, int item, float* scr, int lane) {
    const int nrb = J.nrows >> 6; const int kb = item / nrb, rb = item - kb * nrb; const int k0 = kb * 64, r0 = rb * 64;
    const float* src; bool valid = true;
    if (J.mode == 0) { src = J.srcA + r0; valid = r0 < J.nvalid; }
    else { const int uu = r0 >> 8, j = r0 & 255; src = (j < 128) ? J.srcA + uu * 128 + j : J.srcB + uu * 128 + (j - 128); }
    const int n2 = (lane & 31) * 2, kr = lane >> 5;
    const float* sp = src + (size_t)(k0 + kr) * J.ld + n2;
    f32x2 v[32];
#pragma unroll
    for (int i = 0; i < 32; ++i) v[i] = valid ? *(const f32x2*)(sp + (size_t)(2 * i) * J.ld) : (f32x2){0.f, 0.f};
    const int c = lane & 7;
    f32x4 g0 = (f32x4){1.f, 1.f, 1.f, 1.f}, g1 = g0;
    if (J.g) { g0 = *(const f32x4*)(J.g + k0 + 8 * c); g1 = *(const f32x4*)(J.g + k0 + 8 * c + 4); }
#pragma unroll
    for (int i = 0; i < 32; ++i) { scr[(2 * i + kr) * 65 + n2] = v[i].x; scr[(2 * i + kr) * 65 + n2 + 1] = v[i].y; }
    LDS_FENCE();
#pragma unroll
    for (int j = 0; j < 8; ++j) { const int n = (lane >> 3) + 8 * j; const float* s = scr + (8 * c) * 65 + n;
        u32x4 o; o.x = pk2(s[0 * 65] * g0[0], s[1 * 65] * g0[1]); o.y = pk2(s[2 * 65] * g0[2], s[3 * 65] * g0[3]); o.z = pk2(s[4 * 65] * g1[0], s[5 * 65] * g1[1]); o.w = pk2(s[6 * 65] * g1[2], s[7 * 65] * g1[3]);
        *(u32x4*)(J.dst + (size_t)(r0 + n) * J.K + k0 + 8 * c) = o; }
    LDS_FENCE();
}
constexpr int NJOBS = 13;
__device__ __forceinline__ CvtJob get_job(const Params& P, int j) {
    CvtJob J; J.srcB = nullptr; J.g = nullptr; J.mode = 0;
    unsigned char* ws = opqp(P.ws);
    switch (j) {
    case 0: J.srcA = P.in[I_SCWIN]; J.g = P.in[I_GMIX]; J.dst = (bf16_t*)(ws + O_W1); J.K = 2048; J.ld = 6144; J.nrows = 2048; J.nvalid = 2048; break;
    case 1: J.srcA = P.in[I_SCWIN] + 2048; J.srcB = P.in[I_SCWIN] + 4096; J.g = P.in[I_GMIX]; J.dst = (bf16_t*)(ws + O_W1) + (size_t)2048 * 2048; J.K = 2048; J.ld = 6144; J.nrows = 4096; J.nvalid = 4096; J.mode = 1; break;
    case 2: J.srcA = P.in[I_SCWOUT]; J.dst = (bf16_t*)(ws + O_W2); J.K = 2048; J.ld = 2048; J.nrows = 2048; J.nvalid = 2048; break;
    case 3: case 4: { const int l = j - 3; J.srcA = P.in[I_WGATE] + (size_t)l * DM * DFF; J.srcB = P.in[I_WUP] + (size_t)l * DM * DFF; J.g = P.in[I_GFFN] + l * DM;
        J.dst = (bf16_t*)(ws + O_W3 + l * SZ_W3); J.K = 2048; J.ld = DFF; J.nrows = 11264; J.nvalid = 11264; J.mode = 1; break; }
    case 5: case 6: { const int l = j - 5; J.srcA = P.in[I_WDOWN] + (size_t)l * DFF * DM; J.dst = (bf16_t*)(ws + O_W4 + l * SZ_W4); J.K = DFF; J.ld = 2048; J.nrows = 2048; J.nvalid = 2048; break; }
    case 7: case 8: { const int l = j - 7; J.srcA = P.in[I_PLEGATE] + (size_t)l * DM * DM; J.g = P.in[I_GPLE] + l * DM; J.dst = (bf16_t*)(ws + O_W5 + l * SZ_W5); J.K = 2048; J.ld = 2048; J.nrows = 2048; J.nvalid = 2048; break; }
    case 9: case 10: { const int l = j - 9; J.srcA = P.in[I_PLEPROJ] + (size_t)l * 256 * DM; J.dst = (bf16_t*)(ws + O_WP + l * SZ_WP); J.K = 256; J.ld = 2048; J.nrows = 2048; J.nvalid = 2048; break; }
    case 11: J.srcA = P.in[I_SSDWIN]; J.g = P.in[I_GMIX] + DM; J.dst = (bf16_t*)(ws + O_W6); J.K = 2048; J.ld = NSSD; J.nrows = NSSDP; J.nvalid = NSSD; break;
    default: J.srcA = P.in[I_SSDWOUT]; J.dst = (bf16_t*)(ws + O_W7); J.K = 4096; J.ld = 2048; J.nrows = 2048; J.nvalid = 2048; break;
    }
    return J;
}
__device__ __forceinline__ int job_items(int j) {
    switch (j) { case 0: return 32 * 32; case 1: return 32 * 64; case 2: return 32 * 32; case 3: case 4: return 32 * 176; case 5: case 6: return 88 * 32;
                 case 7: case 8: return 32 * 32; case 9: case 10: return 4 * 32; case 11: return 32 * 164; default: return 64 * 32; }
}
__device__ __forceinline__ void cvt_jobs(const Params& P, unsigned char* smem, const unsigned mask, const int widx, const int nw) {
    const int tidq = opq(threadIdx.x); const int lane = tidq & 63, wave = tidq >> 6;
    float* scr = (float*)(smem) + wave * (64 * 65);
    int base = 0;
#pragma unroll 1
    for (int j = 0; j < NJOBS; ++j) {
        if (!((mask >> j) & 1u)) continue;
        const CvtJob J = get_job(P, j); const int ni = job_items(j);
        int first = (widx - (base % nw) + nw) % nw;
        for (int it = first; it < ni; it += nw) cvt_item(J, it, scr, lane);
        base += ni;
    }
}
__device__ __forceinline__ void phase0(const Params& P, unsigned char* smem) {
    const int tid = opq(threadIdx.x), lane = tid & 63, wave = tid >> 6;
    const int gw = blockIdx.x * 8 + wave, NGW = 2048;
    unsigned char* ws = opqp(P.ws);
    float* H = (float*)(ws + O_H); bf16_t* HB = (bf16_t*)(ws + O_HB); float* SS = (float*)(ws + O_SS);
    for (int r = gw; r < NTOK; r += NGW) {
        const float* xr = (r < NPR) ? P.in[I_XP] + (size_t)r * DM : P.in[I_XS] + (size_t)(r - NPR) * DM;
        float s = 0.f;
#pragma unroll
        for (int j = 0; j < 8; ++j) { const int c = (j * 64 + lane) * 4; const f32x4 v = *(const f32x4*)(xr + c);
            u32x2 w; w.x = pk2(v[0], v[1]); w.y = pk2(v[2], v[3]); *(u32x2*)(HB + (size_t)r * DM + c) = w;
            s += v[0] * v[0] + v[1] * v[1] + v[2] * v[2] + v[3] * v[3]; }
        s = wave_sum(s);
        if (lane == 0) SS[r] = s;
    }
    const int gt = blockIdx.x * 512 + tid, NGT = 131072;
    for (int i = gt; i < 6 * NTOK; i += NGT) SS[NTOK + i] = 0.f;
    bf16_t* PB = (bf16_t*)(ws + O_PB);
    for (int i = gt; i < 2 * NTOK * 64; i += NGT) {
        const int l = i / (NTOK * 64), rem = i - l * (NTOK * 64), r = rem >> 6, c = (rem & 63) * 4;
        const float* src = (r < NPR) ? P.in[I_PP] + ((size_t)l * NPR + r) * 256 + c : P.in[I_PS] + ((size_t)l * 1024 + (r - NPR)) * 256 + c;
        const f32x4 v = *(const f32x4*)src; u32x2 w; w.x = pk2(v[0], v[1]); w.y = pk2(v[2], v[3]);
        *(u32x2*)(PB + ((size_t)l * NTOK + r) * 256 + c) = w;
    }
    cvt_jobs(P, smem, 0x60F, gw, NGW);
}

__device__ __forceinline__ void sc_conv_phase(const Params& P) {
    unsigned char* ws = opqp(P.ws); bf16_t* BG = (bf16_t*)(ws + O_BG); const bf16_t* U = (const bf16_t*)(ws + O_U);
    const float* wc = P.in[I_SCWCONV]; const float* buf = P.in[I_SSC];
    const int gt = opq(threadIdx.x) + blockIdx.x * 512, NGT = 131072;
    for (int i = gt; i < (NTOK / 4) * 256; i += NGT) {
        const int rb = i >> 8, ch = (i & 255) * 8, r0 = rb * 4;
        float w0[8], w1[8], w2[8];
#pragma unroll
        for (int e = 0; e < 8; e += 4) { *(f32x4*)(w0 + e) = *(const f32x4*)(wc + ch + e); *(f32x4*)(w1 + e) = *(const f32x4*)(wc + DM + ch + e); *(f32x4*)(w2 + e) = *(const f32x4*)(wc + 2 * DM + ch + e); }
        float um2[8], um1[8];
        const bool pr = r0 < NPR; const int t0 = pr ? (r0 & 2047) : ((r0 - NPR) & 7);
        if (t0 == 0) {
            if (pr) {
#pragma unroll
                for (int e = 0; e < 8; ++e) { um2[e] = 0.f; um1[e] = 0.f; }
            } else { const int b = (r0 - NPR) >> 3;
#pragma unroll
                for (int e = 0; e < 8; e += 4) { *(f32x4*)(um2 + e) = *(const f32x4*)(buf + ((size_t)b * 2 + 0) * DM + ch + e); *(f32x4*)(um1 + e) = *(const f32x4*)(buf + ((size_t)b * 2 + 1) * DM + ch + e); } }
        } else {
            unpack8(*(const u32x4*)(U + (size_t)(r0 - 2) * DM + ch), um2); unpack8(*(const u32x4*)(U + (size_t)(r0 - 1) * DM + ch), um1);
        }
#pragma unroll
        for (int j = 0; j < 4; ++j) {
            float uc[8], bg[8], o[8];
            unpack8(*(const u32x4*)(U + (size_t)(r0 + j) * DM + ch), uc); unpack8(*(const u32x4*)(BG + (size_t)(r0 + j) * DM + ch), bg);
#pragma unroll
            for (int e = 0; e < 8; ++e) { o[e] = bg[e] * (w0[e] * um2[e] + w1[e] * um1[e] + w2[e] * uc[e]); um2[e] = um1[e]; um1[e] = uc[e]; }
            *(u32x4*)(BG + (size_t)(r0 + j) * DM + ch) = pack8(o);
        }
    }
}

constexpr int LST = 136;
__device__ __forceinline__ bf16x8 lds_frag(const bf16_t* base, int row, int col) { return *(const bf16x8*)(base + row * LST + col); }

__device__ __forceinline__ void ssd_prompt_item(const Params& P, int item, unsigned char* smem) {
    const int tid = opq(threadIdx.x), lane = tid & 63, wid = tid >> 6, fr = lane & 15, fq = lane >> 4;
    const int g = item & 7, c = (item >> 3) & 15, b = item >> 7;
    const int row0 = b * 2048 + c * 128;
    unsigned char* ws = opqp(P.ws);
    const bf16_t* XBC = (const bf16_t*)(ws + O_XBC); const float* DT = (const float*)(ws + O_DT);
    bf16_t* CC = (bf16_t*)(ws + O_CC); bf16_t* XS = (bf16_t*)(ws + O_XS); bf16_t* Y = (bf16_t*)(ws + O_Y); float* SC = (float*)(ws + O_SC); float* ACUM = (float*)(ws + O_ACUM);
    const float* cw = P.in[I_SSDCONVW]; const float* cb = P.in[I_SSDCONVB];
    bf16_t* Cs = (bf16_t*)(smem); bf16_t* Bs = (bf16_t*)(smem + 34816); bf16_t* BTs = (bf16_t*)(smem + 2 * 34816); bf16_t* CBs = (bf16_t*)(smem + 3 * 34816);
    bf16_t* XT = Cs; bf16_t* XD = (bf16_t*)(smem + 17408);
    float* acs_all = (float*)(smem + 4 * 34816); float* dts_all = acs_all + 1024; float* wts = dts_all + 1024;
    {
        const int h = g * 8 + wid;
        const float A = -__expf(P.in[I_ALOG][h]); const float db = P.in[I_DTB][h];
        const float d0 = softplus_f(DT[(size_t)(row0 + 2 * lane) * 64 + h] + db), d1 = softplus_f(DT[(size_t)(row0 + 2 * lane + 1) * 64 + h] + db);
        const float a0 = d0 * A, a1 = d1 * A; float s = a0 + a1;
#pragma unroll
        for (int o = 1; o < 64; o <<= 1) { const float v = __shfl_up(s, o); if (lane >= o) s += v; }
        acs_all[wid * 128 + 2 * lane] = s - a1; acs_all[wid * 128 + 2 * lane + 1] = s; dts_all[wid * 128 + 2 * lane] = d0; dts_all[wid * 128 + 2 * lane + 1] = d1;
        f32x2 av; av.x = s - a1; av.y = s;
        *(f32x2*)(ACUM + ((size_t)(b * 64 + h)) * 2048 + c * 128 + 2 * lane) = av;
#pragma unroll
        for (int k = 0; k < 4; ++k) wts[k * 512 + tid] = cw[(size_t)k * CONVD + g * 512 + tid];
        wts[4 * 512 + tid] = cb[g * 512 + tid];
    }
    {
        const int n0 = (tid & 15) * 8, r = tid >> 4;
#pragma unroll 1
        for (int mat = 0; mat < 2; ++mat) {
            const int ch = DIN + mat * 1024 + g * 128 + n0;
            float w[4][8], bias[8];
#pragma unroll
            for (int k = 0; k < 4; ++k) { *(f32x4*)(w[k]) = *(const f32x4*)(cw + (size_t)k * CONVD + ch); *(f32x4*)(w[k] + 4) = *(const f32x4*)(cw + (size_t)k * CONVD + ch + 4); }
            *(f32x4*)(bias) = *(const f32x4*)(cb + ch); *(f32x4*)(bias + 4) = *(const f32x4*)(cb + ch + 4);
            u32x4 xr[7];
#pragma unroll
            for (int j = 0; j < 7; ++j) { const int t = 4 * r - 3 + j; const bool ok = (c > 0) || (t >= 0);
                xr[j] = ok ? *(const u32x4*)(XBC + (size_t)(row0 + t) * CONVD + ch) : (u32x4){0u, 0u, 0u, 0u}; }
            float o[4][8];
#pragma unroll
            for (int i = 0; i < 4; ++i) {
                float x0[8], x1[8], x2[8], x3[8]; unpack8(xr[i], x0); unpack8(xr[i + 1], x1); unpack8(xr[i + 2], x2); unpack8(xr[i + 3], x3);
#pragma unroll
                for (int e = 0; e < 8; ++e) o[i][e] = silu_f(w[0][e] * x0[e] + w[1][e] * x1[e] + w[2][e] * x2[e] + w[3][e] * x3[e] + bias[e]);
            }
            if (mat == 0) {
#pragma unroll
                for (int i = 0; i < 4; ++i) *(u32x4*)(Bs + (4 * r + i) * LST + n0) = pack8(o[i]);
#pragma unroll
                for (int e = 0; e < 8; ++e) { u32x2 w2; w2.x = pk2(o[0][e], o[1][e]); w2.y = pk2(o[2][e], o[3][e]); *(u32x2*)(BTs + (n0 + e) * LST + 4 * r) = w2; }
            } else {
#pragma unroll
                for (int i = 0; i < 4; ++i) { const u32x4 pw = pack8(o[i]); *(u32x4*)(Cs + (4 * r + i) * LST + n0) = pw; *(u32x4*)(CC + (size_t)(row0 + 4 * r + i) * 1024 + g * 128 + n0) = pw; }
            }
        }
    }
    const int p0 = (tid & 7) * 8, xr_r = tid >> 3;
    u32x4 xr[5];
#pragma unroll
    for (int j = 0; j < 5; ++j) { const int t = 2 * xr_r - 3 + j; const bool ok = (c > 0) || (t >= 0);
        xr[j] = ok ? *(const u32x4*)(XBC + (size_t)(row0 + t) * CONVD + (g * 8) * 64 + p0) : (u32x4){0u, 0u, 0u, 0u}; }
    LDS_BARRIER();
    {
        f32x4 acc[8];
#pragma unroll
        for (int j = 0; j < 8; ++j) acc[j] = (f32x4){0.f, 0.f, 0.f, 0.f};
#pragma unroll
        for (int kk = 0; kk < 4; ++kk) {
            const bf16x8 a = lds_frag(Cs, 16 * wid + fr, 32 * kk + 8 * fq);
#pragma unroll
            for (int j = 0; j < 8; ++j) if (j <= wid) { const bf16x8 bb = lds_frag(Bs, 16 * j + fr, 32 * kk + 8 * fq); acc[j] = __builtin_amdgcn_mfma_f32_16x16x32_bf16(bb, a, acc[j], 0, 0, 0); }
        }
#pragma unroll
        for (int j = 0; j < 8; ++j) if (j <= wid) { u32x2 w2; w2.x = pk2(acc[j][0], acc[j][1]); w2.y = pk2(acc[j][2], acc[j][3]); *(u32x2*)(CBs + (16 * wid + fr) * LST + 16 * j + 4 * fq) = w2; }
    }
    LDS_BARRIER();
#pragma unroll 1
    for (int hh = 0; hh < 8; ++hh) {
        const int h = g * 8 + hh;
        const float* acs = acs_all + hh * 128; const float* dts = dts_all + hh * 128;
        {
            const int r = xr_r; const int ch = h * 64 + p0;
            float o[2][8];
            {
                float w[4][8], bias[8];
#pragma unroll
                for (int k = 0; k < 4; ++k) { *(f32x4*)(w[k]) = *(const f32x4*)(wts + k * 512 + hh * 64 + p0); *(f32x4*)(w[k] + 4) = *(const f32x4*)(wts + k * 512 + hh * 64 + p0 + 4); }
                *(f32x4*)(bias) = *(const f32x4*)(wts + 4 * 512 + hh * 64 + p0); *(f32x4*)(bias + 4) = *(const f32x4*)(wts + 4 * 512 + hh * 64 + p0 + 4);
#pragma unroll
                for (int i = 0; i < 2; ++i) {
                    float x0[8], x1[8], x2[8], x3[8]; unpack8(xr[i], x0); unpack8(xr[i + 1], x1); unpack8(xr[i + 2], x2); unpack8(xr[i + 3], x3);
#pragma unroll
                    for (int e = 0; e < 8; ++e) o[i][e] = silu_f(w[0][e] * x0[e] + w[1][e] * x1[e] + w[2][e] * x2[e] + w[3][e] * x3[e] + bias[e]);
                }
            }
            if (hh < 7) {
#pragma unroll
                for (int j = 0; j < 5; ++j) { const int t = 2 * r - 3 + j; const bool ok = (c > 0) || (t >= 0);
                    xr[j] = ok ? *(const u32x4*)(XBC + (size_t)(row0 + t) * CONVD + (h + 1) * 64 + p0) : (u32x4){0u, 0u, 0u, 0u}; }
            }
            const float aend = acs[127];
            const float d0 = dts[2 * r], d1 = dts[2 * r + 1];
            const float e0 = d0 * __expf(aend - acs[2 * r]), e1 = d1 * __expf(aend - acs[2 * r + 1]);
#pragma unroll
            for (int e = 0; e < 8; ++e) {
                *(unsigned*)(XT + (p0 + e) * LST + 2 * r) = pk2(o[0][e] * d0, o[1][e] * d1);
                *(unsigned*)(XD + (p0 + e) * LST + 2 * r) = pk2(o[0][e] * e0, o[1][e] * e1);
            }
        }
        LDS_BARRIER();
        {
            const int t = 16 * wid + fr; const float at = acs[t];
            const float dsk = P.in[I_SSDD][h] * __builtin_amdgcn_rcpf(fmaxf(dts[t], 1e-30f));
            f32x4 acc[4];
#pragma unroll
            for (int j = 0; j < 4; ++j) acc[j] = (f32x4){0.f, 0.f, 0.f, 0.f};
#pragma unroll
            for (int kk = 0; kk < 4; ++kk) if (32 * kk <= 16 * wid + 15) {
                const int s0 = 32 * kk + 8 * fq;
                float cbv[8]; unpack8(*(const u32x4*)(CBs + t * LST + s0), cbv);
                float as[8]; *(f32x4*)(as) = *(const f32x4*)(acs + s0); *(f32x4*)(as + 4) = *(const f32x4*)(acs + s0 + 4);
                float mv[8];
#pragma unroll
                for (int e = 0; e < 8; ++e) mv[e] = (s0 + e < t) ? cbv[e] * __expf(at - as[e]) : ((s0 + e == t) ? cbv[e] + dsk : 0.f);
                const u32x4 mp = pack8(mv); const bf16x8 a = *(const bf16x8*)&mp;
#pragma unroll
                for (int j = 0; j < 4; ++j) { const bf16x8 bb = lds_frag(XT, 16 * j + fr, 32 * kk + 8 * fq); acc[j] = __builtin_amdgcn_mfma_f32_16x16x32_bf16(bb, a, acc[j], 0, 0, 0); }
            }
#pragma unroll
            for (int j = 0; j < 4; ++j) { u32x2 w2; w2.x = pk2(acc[j][0], acc[j][1]); w2.y = pk2(acc[j][2], acc[j][3]);
                *(u32x2*)(Y + (size_t)(row0 + t) * DIN + h * 64 + 16 * j + 4 * fq) = w2; }
        }
        {
            f32x4 acc[4];
#pragma unroll
            for (int j = 0; j < 4; ++j) acc[j] = (f32x4){0.f, 0.f, 0.f, 0.f};
#pragma unroll
            for (int kk = 0; kk < 4; ++kk) {
                const bf16x8 xb = lds_frag(BTs, 16 * wid + fr, 32 * kk + 8 * fq);
#pragma unroll
                for (int j = 0; j < 4; ++j) { const bf16x8 yb = lds_frag(XD, 16 * j + fr, 32 * kk + 8 * fq); acc[j] = __builtin_amdgcn_mfma_f32_16x16x32_bf16(xb, yb, acc[j], 0, 0, 0); }
            }
            bf16_t* scb = (bf16_t*)SC + ((size_t)((b * 16 + c) * 64 + h)) * 64 * 128;
#pragma unroll
            for (int j = 0; j < 4; ++j) { u32x2 w2; w2.x = pk2(acc[j][0], acc[j][1]); w2.y = pk2(acc[j][2], acc[j][3]); *(u32x2*)(scb + (size_t)(16 * j + fr) * 128 + 16 * wid + 4 * fq) = w2; }
        }
        LDS_BARRIER();
    }
}

__device__ __forceinline__ void ssd_sample_item(const Params& P, int item, unsigned char* smem) {
    const int tid = opq(threadIdx.x), lane = tid & 63, wid = tid >> 6, fr = lane & 15, fq = lane >> 4;
    const int g = item & 7, b = item >> 3, h = g * 8 + wid;
    const int R0 = NPR + b * 8;
    unsigned char* ws = opqp(P.ws);
    const bf16_t* XBC = (const bf16_t*)(ws + O_XBC); const float* DT = (const float*)(ws + O_DT); bf16_t* Y = (bf16_t*)(ws + O_Y);
    const float* cw = P.in[I_SSDCONVW]; const float* cbias = P.in[I_SSDCONVB]; const float* cbuf = P.in[I_SSDC] + (size_t)b * 3 * CONVD;
    const float* st_in = P.in[I_SSD] + ((size_t)(b * 64 + h)) * 64 * 128; float* st_out = P.out + OO_SSDS + ((size_t)(b * 64 + h)) * 64 * 128;
    float* Bsm = (float*)smem;
    float* Csm = Bsm + 1024;
    float* cbs = Csm + 1024;
    float* yis = cbs + 64 + wid * 512;
    bf16_t* C16 = (bf16_t*)(smem + 24832);
    bf16_t* BT16 = C16 + 1024;
    bf16_t* xw16 = BT16 + 1024 + wid * 512;
    LDS_BARRIER();
    {
        const int mat = tid >> 8, t = (tid >> 5) & 7, n4 = (tid & 31) * 4;
        const int ch = DIN + mat * 1024 + g * 128 + n4;
        f32x4 accv = *(const f32x4*)(cbias + ch);
#pragma unroll
        for (int k = 0; k < 4; ++k) {
            const int j = t + k; f32x4 xv;
            if (j < 3) xv = *(const f32x4*)(cbuf + (size_t)j * CONVD + ch);
            else { const u32x2 pw = *(const u32x2*)(XBC + (size_t)(R0 + j - 3) * CONVD + ch); xv = (f32x4){bflo(pw.x), bfhi(pw.x), bflo(pw.y), bfhi(pw.y)}; }
            accv += *(const f32x4*)(cw + (size_t)k * CONVD + ch) * xv;
        }
        f32x4 o; o[0] = silu_f(accv[0]); o[1] = silu_f(accv[1]); o[2] = silu_f(accv[2]); o[3] = silu_f(accv[3]);
        *(f32x4*)((mat ? Csm : Bsm) + t * 128 + n4) = o;
        const unsigned p01 = pk2(o[0], o[1]), p23 = pk2(o[2], o[3]);
        if (mat) { u32x2 w2; w2.x = p01; w2.y = p23; *(u32x2*)(C16 + t * 128 + n4) = w2; }
        else { BT16[(n4 + 0) * 8 + t] = (bf16_t)(p01 & 0xffffu); BT16[(n4 + 1) * 8 + t] = (bf16_t)(p01 >> 16); BT16[(n4 + 2) * 8 + t] = (bf16_t)(p23 & 0xffffu); BT16[(n4 + 3) * 8 + t] = (bf16_t)(p23 >> 16); }
    }
    float xs[8], dtv[8], ac[8];
    {
        const int ch = h * 64 + lane;
        float up[11];
#pragma unroll
        for (int j = 0; j < 3; ++j) up[j] = cbuf[(size_t)j * CONVD + ch];
#pragma unroll
        for (int j = 0; j < 8; ++j) up[3 + j] = __uint_as_float((unsigned)XBC[(size_t)(R0 + j) * CONVD + ch] << 16);
        const float w0 = cw[ch], w1 = cw[CONVD + ch], w2 = cw[2 * CONVD + ch], w3 = cw[3 * CONVD + ch], bs = cbias[ch];
#pragma unroll
        for (int t = 0; t < 8; ++t) xs[t] = silu_f(w0 * up[t] + w1 * up[t + 1] + w2 * up[t + 2] + w3 * up[t + 3] + bs);
        const float A = -__expf(P.in[I_ALOG][h]); const float db = P.in[I_DTB][h];
        float run = 0.f;
#pragma unroll
        for (int t = 0; t < 8; ++t) { dtv[t] = softplus_f(DT[(size_t)(R0 + t) * 64 + h] + db); run += dtv[t] * A; ac[t] = run; }
    }
    {
        float v[8];
#pragma unroll
        for (int s = 0; s < 8; ++s) v[s] = __expf(ac[7] - ac[s]) * dtv[s] * xs[s];
        *(u32x4*)(xw16 + lane * 8) = pack8(v);
    }
    LDS_BARRIER();
    {
        const int s = lane & 7, part = lane >> 3;
        float d = 0.f;
#pragma unroll
        for (int n = 0; n < 16; ++n) d += Csm[wid * 128 + part * 16 + n] * Bsm[s * 128 + part * 16 + n];
        d += __shfl_xor(d, 8); d += __shfl_xor(d, 16); d += __shfl_xor(d, 32);
        if (lane < 8) cbs[wid * 8 + lane] = d;
    }
    {
        const float ee = __expf(ac[7]);
        const bf16x8 zero8 = (bf16x8){0, 0, 0, 0, 0, 0, 0, 0};
        bf16x8 cfrag[4], btf[8];
#pragma unroll
        for (int kk = 0; kk < 4; ++kk) cfrag[kk] = (fr < 8) ? *(const bf16x8*)(C16 + fr * 128 + 32 * kk + 8 * fq) : zero8;
#pragma unroll
        for (int nt = 0; nt < 8; ++nt) btf[nt] = (fq == 0) ? *(const bf16x8*)(BT16 + (16 * nt + fr) * 8) : zero8;
#pragma unroll
        for (int j = 0; j < 4; ++j) {
            const float* hp = st_in + (size_t)(16 * j + fr) * 128;
            f32x4 hb[4][2], hc[8];
#pragma unroll
            for (int kk = 0; kk < 4; ++kk) { hb[kk][0] = *(const f32x4*)(hp + 32 * kk + 8 * fq); hb[kk][1] = *(const f32x4*)(hp + 32 * kk + 8 * fq + 4); }
#pragma unroll
            for (int nt = 0; nt < 8; ++nt) hc[nt] = *(const f32x4*)(hp + 16 * nt + 4 * fq);
            f32x4 ya = (f32x4){0.f, 0.f, 0.f, 0.f};
#pragma unroll
            for (int kk = 0; kk < 4; ++kk) {
                u32x4 hw; hw.x = pk2(hb[kk][0][0], hb[kk][0][1]); hw.y = pk2(hb[kk][0][2], hb[kk][0][3]); hw.z = pk2(hb[kk][1][0], hb[kk][1][1]); hw.w = pk2(hb[kk][1][2], hb[kk][1][3]);
                ya = __builtin_amdgcn_mfma_f32_16x16x32_bf16(cfrag[kk], *(const bf16x8*)&hw, ya, 0, 0, 0);
            }
            if (fq < 2) {
#pragma unroll
                for (int jj = 0; jj < 4; ++jj) yis[(4 * fq + jj) * 64 + 16 * j + fr] = ya[jj];
            }
            const bf16x8 xf = (fq == 0) ? *(const bf16x8*)(xw16 + (16 * j + fr) * 8) : zero8;
            float* op = st_out + (size_t)(16 * j + fr) * 128;
#pragma unroll
            for (int nt = 0; nt < 8; ++nt) {
                const f32x4 d = __builtin_amdgcn_mfma_f32_16x16x32_bf16(btf[nt], xf, hc[nt] * ee, 0, 0, 0);
                *(f32x4*)(op + 16 * nt + 4 * fq) = d;
            }
        }
    }
    LDS_BARRIER();
#pragma unroll
    for (int t = 0; t < 8; ++t) {
        float a = 0.f;
#pragma unroll
        for (int s = 0; s <= t; ++s) a += cbs[t * 8 + s] * __expf(ac[t] - ac[s]) * dtv[s] * xs[s];
        const float y = a + P.in[I_SSDD][h] * xs[t] + __expf(ac[t]) * yis[t * 64 + lane];
        Y[(size_t)(R0 + t) * DIN + h * 64 + lane] = (bf16_t)(pk2(y, 0.f) & 0xffffu);
    }
}

__device__ __forceinline__ void ssd_scan_item(const Params& P, int item, unsigned char* smem) {
    const int tid = opq(threadIdx.x), lane = tid & 63, wid = tid >> 6, fr = lane & 15, fq = lane >> 4;
    const int b = item >> 6, h = item & 63, g = h >> 3;
    unsigned char* ws = opqp(P.ws);
    const bf16_t* CC = (const bf16_t*)(ws + O_CC); const bf16_t* XS = (const bf16_t*)(ws + O_XS); bf16_t* Y = (bf16_t*)(ws + O_Y);
    const float* SC = (const float*)(ws + O_SC); const float* ACUM = (const float*)(ws + O_ACUM);
    bf16_t* Cs = (bf16_t*)smem; bf16_t* Hs = (bf16_t*)(smem + 34816); float* acs = (float*)(smem + 34816 + 17408);
    const int n4 = (tid & 31) * 4, pb = tid >> 5;
    const int t = 16 * wid + fr;
    f32x4 st[4];
#pragma unroll
    for (int i = 0; i < 4; ++i) st[i] = (f32x4){0.f, 0.f, 0.f, 0.f};
    u32x4 cpf[4]; float acv = 0.f; u32x2 ywn[4]; u32x2 scn[4];
#define SCAN_PREFETCH(cn) do { const int _row0 = b * 2048 + (cn) * 128; \
        _Pragma("unroll") for (int i = 0; i < 4; ++i) { const int piece = tid + 512 * i, r = piece >> 4, q = piece & 15; cpf[i] = *(const u32x4*)(CC + (size_t)(_row0 + r) * 1024 + g * 128 + q * 8); } \
        if (tid < 128) acv = ACUM[((size_t)(b * 64 + h)) * 2048 + (cn) * 128 + tid]; \
        _Pragma("unroll") for (int j = 0; j < 4; ++j) { const size_t idx = (size_t)(_row0 + t) * DIN + h * 64 + 16 * j + 4 * fq; ywn[j] = *(const u32x2*)(Y + idx); } \
        { const bf16_t* scb = (const bf16_t*)SC + ((size_t)((b * 16 + (cn)) * 64 + h)) * 64 * 128; \
          _Pragma("unroll") for (int i = 0; i < 4; ++i) scn[i] = *(const u32x2*)(scb + (size_t)(pb + 16 * i) * 128 + n4); } } while (0)
    SCAN_PREFETCH(0);
    LDS_BARRIER();
#pragma unroll 1
    for (int c = 0; c < 16; ++c) {
        const int row0 = b * 2048 + c * 128;
#pragma unroll
        for (int i = 0; i < 4; ++i) { const int piece = tid + 512 * i, r = piece >> 4, q = piece & 15; *(u32x4*)(Cs + r * LST + q * 8) = cpf[i]; }
        if (tid < 128) acs[tid] = acv;
#pragma unroll
        for (int i = 0; i < 4; ++i) { u32x2 w2; w2.x = pk2(st[i][0], st[i][1]); w2.y = pk2(st[i][2], st[i][3]); *(u32x2*)(Hs + (pb + 16 * i) * LST + n4) = w2; }
        u32x2 yw[4]; u32x2 scv[4];
#pragma unroll
        for (int j = 0; j < 4; ++j) { yw[j] = ywn[j]; scv[j] = scn[j]; }
        LDS_BARRIER();
        if (c < 15) SCAN_PREFETCH(c + 1);
        {
            f32x4 acc[4];
#pragma unroll
            for (int j = 0; j < 4; ++j) acc[j] = (f32x4){0.f, 0.f, 0.f, 0.f};
#pragma unroll
            for (int kk = 0; kk < 4; ++kk) {
                const bf16x8 a = lds_frag(Cs, 16 * wid + fr, 32 * kk + 8 * fq);
#pragma unroll
                for (int j = 0; j < 4; ++j) { const bf16x8 bb = lds_frag(Hs, 16 * j + fr, 32 * kk + 8 * fq); acc[j] = __builtin_amdgcn_mfma_f32_16x16x32_bf16(bb, a, acc[j], 0, 0, 0); }
            }
            const float et = __expf(acs[t]);
#pragma unroll
            for (int j = 0; j < 4; ++j) {
                const size_t idx = (size_t)(row0 + t) * DIN + h * 64 + 16 * j + 4 * fq;
                const float y0 = bflo(yw[j].x) + et * acc[j][0], y1 = bfhi(yw[j].x) + et * acc[j][1];
                const float y2 = bflo(yw[j].y) + et * acc[j][2], y3 = bfhi(yw[j].y) + et * acc[j][3];
                u32x2 o; o.x = pk2(y0, y1); o.y = pk2(y2, y3); *(u32x2*)(Y + idx) = o;
            }
        }
        {
            const float ec = __expf(acs[127]);
#pragma unroll
            for (int i = 0; i < 4; ++i) st[i] = st[i] * ec + (f32x4){bflo(scv[i].x), bfhi(scv[i].x), bflo(scv[i].y), bfhi(scv[i].y)};
        }
        LDS_BARRIER();
    }
#undef SCAN_PREFETCH
    float* so = P.out + OO_SSDP + ((size_t)(b * 64 + h)) * 64 * 128;
#pragma unroll
    for (int i = 0; i < 4; ++i) *(f32x4*)(so + (size_t)(pb + 16 * i) * 128 + n4) = st[i];
}

__device__ __forceinline__ void ssd_gate_phase(const Params& P) {
    unsigned char* ws = opqp(P.ws); const bf16_t* Y = (const bf16_t*)(ws + O_Y); const bf16_t* Z = (const bf16_t*)(ws + O_Z); bf16_t* A7 = (bf16_t*)(ws + O_A7);
    const float* ng = P.in[I_NORMG];
    const int tidq = opq(threadIdx.x); const int lane = tidq & 63, gw = blockIdx.x * 8 + (tidq >> 6), NGW = 2048;
    for (int it0 = gw * 4; it0 < NTOK * 8; it0 += NGW * 4) {
        u32x4 yv[4], zv[4];
#pragma unroll
        for (int u = 0; u < 4; ++u) { const int it = it0 + u; const size_t idx = (size_t)(it >> 3) * DIN + (it & 7) * 512 + lane * 8; yv[u] = *(const u32x4*)(Y + idx); zv[u] = *(const u32x4*)(Z + idx); }
#pragma unroll
        for (int u = 0; u < 4; ++u) {
            const int it = it0 + u; const int g = it & 7; const size_t idx = (size_t)(it >> 3) * DIN + g * 512 + lane * 8;
            float y[8], z[8], gt[8]; unpack8(yv[u], y); unpack8(zv[u], z);
            float sacc = 0.f;
#pragma unroll
            for (int e = 0; e < 8; ++e) { gt[e] = y[e] * silu_f(z[e]); sacc += gt[e] * gt[e]; }
            sacc = wave_sum(sacc);
            const float sc = rsqrtf(sacc * (1.f / 512.f) + EPSN);
            float gn[8]; *(f32x4*)(gn) = *(const f32x4*)(ng + g * 512 + lane * 8); *(f32x4*)(gn + 4) = *(const f32x4*)(ng + g * 512 + lane * 8 + 4);
#pragma unroll
            for (int e = 0; e < 8; ++e) gt[e] = gt[e] * sc * gn[e];
            *(u32x4*)(A7 + idx) = pack8(gt);
        }
    }
}

__device__ __forceinline__ void final_phase(const Params& P) {
    unsigned char* ws = opqp(P.ws); const float* H = (const float*)(ws + O_H); const float* SS = (const float*)(ws + O_SS) + 6 * NTOK; const float* gf = P.in[I_GFIN];
    const int tidq = opq(threadIdx.x); const int lane = tidq & 63, gw = blockIdx.x * 8 + (tidq >> 6), NGW = 2048;
    for (int r = gw; r < NTOK; r += NGW) {
        const float rs = rstd_of(SS, r);
#pragma unroll
        for (int j = 0; j < 8; ++j) { const int c = (j * 64 + lane) * 4; const f32x4 v = *(const f32x4*)(H + (size_t)r * DM + c); const f32x4 gv = *(const f32x4*)(gf + c);
            *(f32x4*)(P.out + OO_Y + (size_t)r * DM + c) = v * rs * gv; }
    }
}

__global__ void __launch_bounds__(512, 2) hybrid_mega(Params P) {
    extern __shared__ __attribute__((aligned(16))) unsigned char smem[];
    cg::grid_group grid = cg::this_grid();
    LAS unsigned char* lds = (LAS unsigned char*)smem;
    unsigned char* ws = opqp(P.ws);
    float* SS = (float*)(ws + O_SS); float* H = (float*)(ws + O_H);
    bf16_t* HB0 = (bf16_t*)(ws + O_HB); bf16_t* HB1 = (bf16_t*)(ws + O_PP);
    constexpr int G = 256;
    const int c = (int)blockIdx.x;
    pg8::StaticOrder S;

    unsigned* bar = (unsigned*)(ws + O_BAR); volatile LAS unsigned* bst = (volatile LAS unsigned*)(lds + LDS_BAR_OFF);
    xcd_barrier_post(bar, bst);
    phase0(P, smem);
    if (P.out == nullptr) grid.sync();
    xcd_barrier(bar, bst);
#pragma unroll 1
    for (int l = 0; l < 2; ++l) {
        pg8::Gemm gm;
        bf16_t* HB = l ? HB1 : HB0; bf16_t* HBn = l ? HB0 : HB1;
        if (l == 0) {
            constexpr int gs1 = 216;
            {
                pg8::Gemm g1{HB, (const bf16_t*)(ws + O_W1), NTOK, 6144, 2048};
                EpiScIn e{SS, (bf16_t*)(ws + O_BG), (bf16_t*)(ws + O_U), P.out + OO_SCP, P.out + OO_SCS};
                if (c < gs1) { S.init(g1.M, g1.N, gs1, opqs(c)); pg8::gemm_phase(lds, g1, S, e); }
            }
            if (c >= gs1)
#pragma unroll 1
            for (int l2 = 0; l2 < 2; ++l2) {
                pg8::Gemm gp{(const bf16_t*)(ws + O_PB) + (size_t)l2 * NTOK * 256, (const bf16_t*)(ws + O_WP + l2 * SZ_WP), NTOK, 2048, 256};
                EpiPlain e{(bf16_t*)(ws + O_PP) + (size_t)l2 * NTOK * DM};
                S.init(gp.M, gp.N, G - gs1, opqs(c) - gs1); pg8::gemm_phase(lds, gp, S, e);
            }
            xcd_barrier(bar, bst);
            sc_conv_phase(P);
            xcd_barrier(bar, bst);
            gm = pg8::Gemm{(const bf16_t*)(ws + O_BG), (const bf16_t*)(ws + O_W2), NPR, 2048, 2048};
        } else {
            {
                pg8::Gemm g6{HB, (const bf16_t*)(ws + O_W6), NTOK, NSSDP, 2048};
                EpiSsdIn e{SS + 3 * NTOK, (bf16_t*)(ws + O_Z), (bf16_t*)(ws + O_XBC), (float*)(ws + O_DT), P.out + OO_SSDCP, P.out + OO_SSDCS};
                if (c < 246) { S.init(g6.M, g6.N, 246, opqs(c)); pg8::gemm_phase(lds, g6, S, e); }
                else cvt_jobs(P, smem, 1u << 12, (c - 246) * 8 + (opq(threadIdx.x) >> 6), 10 * 8);
            }
            xcd_barrier(bar, bst);
            for (int it = c; it < 512 + 1024; it += G) { if (it < 512) ssd_prompt_item(P, it, smem); else ssd_sample_item(P, it - 512, smem); }
            xcd_barrier(bar, bst);
            for (int it = c; it < 256; it += G) ssd_scan_item(P, it, smem);
            xcd_barrier(bar, bst);
            ssd_gate_phase(P);
            xcd_barrier(bar, bst);
            gm = pg8::Gemm{(const bf16_t*)(ws + O_A7), (const bf16_t*)(ws + O_W7), NPR, 2048, 4096};
        }
        float* ss_l = SS + 3 * l * NTOK;
        {
            const float* hin_main = l ? (const float*)H : P.in[I_XP];
            const float* hin_small = l ? (const float*)H : P.in[I_XS] - (size_t)NPR * DM;
            EpiRes<0> e{H, HB, ss_l + NTOK, nullptr, nullptr, hin_main};
            S.init(gm.M, gm.N, G, opqs(c)); pg8::gemm_phase(lds, gm, S, e);
            for (int u = c; u < 256; u += G) small_gemm_res<0>(smem, gm.A + (size_t)NPR * gm.K, gm.Bt, gm.K, H, hin_small, HB, ss_l + NTOK, nullptr, nullptr, u);
        }
        xcd_barrier(bar, bst);
        {
            pg8::Gemm g3{HB, (const bf16_t*)(ws + O_W3 + l * SZ_W3), NTOK, 11264, 2048};
            EpiGateUp e{ss_l + NTOK, (bf16_t*)(ws + O_ACT)};
            constexpr int gg = 228;
            if (c < gg) { S.init(g3.M, g3.N, gg, opqs(c)); pg8::gemm_phase(lds, g3, S, e); }
            else cvt_jobs(P, smem, l == 0 ? ((1u << 5) | (1u << 7) | (1u << 11) | (1u << 4)) : ((1u << 6) | (1u << 8)), (c - gg) * 8 + (opq(threadIdx.x) >> 6), (G - gg) * 8);
        }
        xcd_barrier(bar, bst);
        {
            pg8::Gemm g4{(const bf16_t*)(ws + O_ACT), (const bf16_t*)(ws + O_W4 + l * SZ_W4), NPR, 2048, DFF};
            EpiRes<0> e{H, HB, ss_l + 2 * NTOK, nullptr, nullptr, H};
            S.init(g4.M, g4.N, G, opqs(c)); pg8::gemm_phase(lds, g4, S, e);
            for (int u = c; u < 256; u += G) small_gemm_res<0>(smem, g4.A + (size_t)NPR * g4.K, g4.Bt, g4.K, H, H, HB, ss_l + 2 * NTOK, nullptr, nullptr, u);
        }
        xcd_barrier(bar, bst);
        {
            pg8::Gemm g5{HB, (const bf16_t*)(ws + O_W5 + l * SZ_W5), NPR, 2048, 2048};
            EpiRes<1> e{H, HBn, ss_l + 3 * NTOK, ss_l + 2 * NTOK, (const bf16_t*)(ws + O_PP) + (size_t)l * NTOK * DM, H};
            S.init(g5.M, g5.N, G, opqs(c)); pg8::gemm_phase(lds, g5, S, e);
            for (int u = c; u < 256; u += G) small_gemm_res<1>(smem, g5.A + (size_t)NPR * g5.K, g5.Bt, g5.K, H, H, HBn, ss_l + 3 * NTOK, ss_l + 2 * NTOK, e.PPl, u);
        }
        xcd_barrier(bar, bst);
    }
    final_phase(P);
}

extern "C" void kernel_launch(void* const* d_in, const int* in_sizes, int n_in, void* d_out, int out_size, void* d_ws, size_t ws_size, hipStream_t stream) {
    static int grid_blocks = 0;
    if (grid_blocks == 0) {
        if (n_in != 27 || ws_size < WS_END) { fprintf(stderr, "kernel_launch: need 27 inputs and %zu B workspace (got %d, %zu)\n", (size_t)WS_END, n_in, ws_size); grid_blocks = -1; return; }
        int dev = 0, cus = 0, per_cu = 0;
        hipGetDevice(&dev);
        hipDeviceGetAttribute(&cus, hipDeviceAttributeMultiprocessorCount, dev);
        if (hipFuncSetAttribute((const void*)hybrid_mega, hipFuncAttributeMaxDynamicSharedMemorySize, LDS_BYTES) != hipSuccess) { fprintf(stderr, "kernel_launch: hipFuncSetAttribute failed\n"); grid_blocks = -1; return; }
        if (hipOccupancyMaxActiveBlocksPerMultiprocessor(&per_cu, (const void*)hybrid_mega, 512, LDS_BYTES) != hipSuccess || per_cu < 1) { fprintf(stderr, "kernel_launch: occupancy query failed (%d)\n", per_cu); grid_blocks = -1; return; }
        if (cus < 256) { fprintf(stderr, "kernel_launch: built for a 256-CU device (got %d CUs)\n", cus); grid_blocks = -1; return; }
        grid_blocks = 256;
    }
    if (grid_blocks < 0) return;
    Params p; memset(&p, 0, sizeof(p));
    for (int i = 0; i < 27; ++i) p.in[i] = (const float*)d_in[i];
    p.out = (float*)d_out; p.ws = (unsigned char*)d_ws;
    (void)hipMemsetAsync((unsigned char*)d_ws + O_BAR, 0, BAR_BYTES, stream);
    void* args[] = {&p};
    hipError_t e = hipLaunchCooperativeKernel((const void*)hybrid_mega, dim3(grid_blocks), dim3(512), args, LDS_BYTES, stream);
    if (e != hipSuccess) fprintf(stderr, "cooperative launch failed: %s (grid %d)\n", hipGetErrorString(e), grid_blocks);
}
```

```cpp
#include <hip/hip_runtime.h>
#include <hip/hip_cooperative_groups.h>
#include <cstdio>
#include <cstring>
namespace cg = cooperative_groups;

#define LAS __attribute__((address_space(3)))
typedef unsigned short bf16_t;
typedef short bf16x8 __attribute__((ext_vector_type(8)));
typedef float f32x4 __attribute__((ext_vector_type(4)));
typedef float f32x2 __attribute__((ext_vector_type(2)));
typedef unsigned u32x4 __attribute__((ext_vector_type(4)));
typedef unsigned u32x2 __attribute__((ext_vector_type(2)));

constexpr int NTOK = 9216, NPR = 8192, DM = 2048, DFF = 5632, DIN = 4096, CONVD = 6144, NSSD = 10304, NSSDP = 10496;
constexpr float EPSN = 1e-6f;
constexpr int LDS_BYTES = 157696 + 16;
constexpr int LDS_BAR_OFF = 157696;

constexpr size_t SZ_W1 = 6144ull * 2048 * 2, SZ_W2 = 2048ull * 2048 * 2, SZ_W3 = 11264ull * 2048 * 2, SZ_W4 = 2048ull * 5632 * 2,
                 SZ_W5 = SZ_W2, SZ_WP = 2048ull * 256 * 2, SZ_W6 = (size_t)NSSDP * 2048 * 2, SZ_W7 = 2048ull * 4096 * 2;
constexpr size_t O_W1 = 0, O_W2 = O_W1 + SZ_W1, O_W3 = O_W2 + SZ_W2, O_W4 = O_W3 + 2 * SZ_W3, O_W5 = O_W4 + 2 * SZ_W4, O_WP = O_W5 + 2 * SZ_W5,
                 O_W6 = O_WP + 2 * SZ_WP, O_W7 = O_W6 + SZ_W6;
constexpr size_t O_H = O_W7 + SZ_W7;
constexpr size_t O_HB = O_H + (size_t)NTOK * DM * 4;
constexpr size_t O_BG = O_HB + (size_t)NTOK * DM * 2;
constexpr size_t O_U = O_BG + (size_t)NTOK * DM * 2;
constexpr size_t O_XS = O_BG;
constexpr size_t O_ACT = O_U + (size_t)NTOK * DM * 2;
constexpr size_t O_A7 = O_ACT;
constexpr size_t O_PB = O_ACT + (size_t)NTOK * DFF * 2;
constexpr size_t O_PP = O_PB + 2ull * NTOK * 256 * 2;
constexpr size_t O_Z = O_PP + 2ull * NTOK * DM * 2;
constexpr size_t O_XBC = O_Z + (size_t)NTOK * DIN * 2;
constexpr size_t O_DT = O_XBC + (size_t)NTOK * CONVD * 2;
constexpr size_t O_CC = O_DT + (size_t)NTOK * 64 * 4;
constexpr size_t O_Y = O_CC + (size_t)NPR * 1024 * 2;
constexpr size_t O_SC = O_Y + (size_t)NTOK * DIN * 2;
constexpr size_t O_ACUM = O_SC + 4ull * 16 * 64 * 64 * 128 * 4;
constexpr size_t O_SS = O_ACUM + 4ull * 64 * 2048 * 4;
constexpr size_t O_BAR = O_SS + 7ull * NTOK * 4;
constexpr size_t BAR_BYTES = 3456 * 4;
constexpr size_t WS_END = O_BAR + BAR_BYTES;
static_assert(WS_END <= (1ull << 30), "workspace too large");

constexpr size_t OO_Y = 0, OO_SCP = (size_t)NTOK * DM, OO_SCS = OO_SCP + 4 * 2 * 2048, OO_SSDCP = OO_SCS + 128 * 2 * 2048,
                 OO_SSDCS = OO_SSDCP + 4 * 3 * CONVD, OO_SSDP = OO_SSDCS + 128 * 3 * CONVD, OO_SSDS = OO_SSDP + 4ull * 64 * 64 * 128;

struct Params { const float* in[27]; float* out; unsigned char* ws; };
enum { I_XP = 0, I_XS, I_PP, I_PS, I_SSC, I_SSDC, I_SSD, I_GMIX, I_GFFN, I_GPLE, I_GFIN, I_SCWIN, I_SCWCONV, I_SCWOUT, I_SSDWIN, I_SSDCONVW, I_SSDCONVB,
       I_DTB, I_ALOG, I_SSDD, I_NORMG, I_SSDWOUT, I_WGATE, I_WUP, I_WDOWN, I_PLEPROJ, I_PLEGATE };

__device__ __forceinline__ unsigned pk2(float lo, float hi) { unsigned r; asm volatile("v_cvt_pk_bf16_f32 %0, %1, %2" : "=v"(r) : "v"(lo), "v"(hi)); return r; }
__device__ __forceinline__ float bflo(unsigned w) { return __uint_as_float(w << 16); }
__device__ __forceinline__ float bfhi(unsigned w) { return __uint_as_float(w & 0xffff0000u); }
__device__ __forceinline__ float wave_sum(float v) {
#pragma unroll
    for (int o = 1; o < 64; o <<= 1) v += __shfl_xor(v, o);
    return v;
}
__device__ __forceinline__ float silu_f(float x) { return x * __builtin_amdgcn_rcpf(1.f + __expf(-x)); }
__device__ __forceinline__ float sigmoid_f(float x) { return __builtin_amdgcn_rcpf(1.f + __expf(-x)); }
__device__ __forceinline__ float softplus_f(float x) { return x > 20.f ? x : log1pf(__expf(x)); }
__device__ __forceinline__ void unpack8(const u32x4 w, float (&f)[8]) {
    f[0] = bflo(w.x); f[1] = bfhi(w.x); f[2] = bflo(w.y); f[3] = bfhi(w.y); f[4] = bflo(w.z); f[5] = bfhi(w.z); f[6] = bflo(w.w); f[7] = bfhi(w.w);
}
__device__ __forceinline__ u32x4 pack8(const float (&f)[8]) { u32x4 w; w.x = pk2(f[0], f[1]); w.y = pk2(f[2], f[3]); w.z = pk2(f[4], f[5]); w.w = pk2(f[6], f[7]); return w; }
#define LDS_FENCE() asm volatile("s_waitcnt lgkmcnt(0)" ::: "memory")
#define LDS_BARRIER() do { asm volatile("s_waitcnt lgkmcnt(0)" ::: "memory"); __builtin_amdgcn_s_barrier(); asm volatile("" ::: "memory"); } while (0)
__device__ __forceinline__ int opq(int x) { asm volatile("" : "+v"(x)); return x; }
__device__ __forceinline__ int opqs(int x) { asm volatile("" : "+s"(x)); return x; }
template <class T> __device__ __forceinline__ T* opqp(T* p) { asm volatile("" : "+s"(p)); return p; }


#define XB_TMO      128
#define XB_XCNT(j)  (256  + 64 * (j))
#define XB_XSUB(j)  (1280 + 64 * (j))
#define XB_XGEN(j)  (2304 + 64 * (j))
#define XB_TOP      3328
#define XB_TOPGEN   3392
#define XB_SPIN_CAP (1u << 18)
__device__ __forceinline__ unsigned xb_ld(unsigned* p)              { return __hip_atomic_load(p, __ATOMIC_RELAXED, __HIP_MEMORY_SCOPE_AGENT); }
__device__ __forceinline__ unsigned xb_add(unsigned* p, unsigned v) { return __hip_atomic_fetch_add(p, v, __ATOMIC_RELAXED, __HIP_MEMORY_SCOPE_AGENT); }
__device__ __forceinline__ unsigned xb_xcc_id() { return (unsigned)__builtin_amdgcn_s_getreg((3 << 11) | 20) & 0xFu; }
#define XB_SPIN(cond, bar) do { unsigned _sp = 0; while (cond) { __builtin_amdgcn_s_sleep(1); \
    if ((++_sp & 255u) == 0u) { if (xb_ld(&(bar)[XB_TMO])) break; if (_sp > XB_SPIN_CAP) { atomicAdd(&(bar)[XB_TMO], 1u); break; } } } } while (0)
__device__ __forceinline__ void xcd_barrier_complete(unsigned* bar, unsigned x, unsigned& nloc, unsigned& nx) {
    const unsigned G = gridDim.x * gridDim.y * gridDim.z;
    unsigned sum, cnt, mine, sp = 0u;
    for (;;) {
        sum = 0u; cnt = 0u; mine = 0u;
#pragma unroll
        for (unsigned j = 0; j < 16; ++j) { const unsigned c = xb_ld(&bar[XB_XCNT(j)]); sum += c; cnt += (c > 0u) ? 1u : 0u; mine = (j == x) ? c : mine; }
        if (sum == G) break;
        __builtin_amdgcn_s_sleep(1);
        if ((++sp & 255u) == 0u) { if (xb_ld(&bar[XB_TMO])) break; if (sp > XB_SPIN_CAP) { atomicAdd(&bar[XB_TMO], 1u); break; } }
    }
    nloc = mine > 0u ? mine : 1u; nx = cnt > 0u ? cnt : 1u;
}
__device__ __forceinline__ void xcd_barrier_post(unsigned* bar, volatile LAS unsigned* st) {
    if (threadIdx.x == 0) { st[0] = 0u; st[1] = 0u; (void)xb_add(&bar[XB_XCNT(xb_xcc_id())], 1u); }
    __syncthreads();
}
__device__ __forceinline__ void xcd_barrier(unsigned* bar, volatile LAS unsigned* st) {
    asm volatile("s_waitcnt vmcnt(0)" ::: "memory");
    __syncthreads();
    if (threadIdx.x == 0) {
        __builtin_amdgcn_s_waitcnt(0);
        const unsigned x = xb_xcc_id();
        unsigned nloc = st[0], nx = st[1];
        if (nloc == 0u) { xcd_barrier_complete(bar, x, nloc, nx); st[0] = nloc; st[1] = nx; }
        const unsigned old = xb_add(&bar[XB_XSUB(x)], 1u);
        const unsigned gen = old / nloc;
        if (old + 1u == (gen + 1u) * nloc) {
            __builtin_amdgcn_fence(__ATOMIC_RELEASE, "agent");
            asm volatile("s_waitcnt vmcnt(0)" ::: "memory");
            const unsigned og = xb_add(&bar[XB_TOP], 1u);
            const unsigned tg = og / nx;
            if (og + 1u == (tg + 1u) * nx) xb_add(&bar[XB_TOPGEN], 1u);
            else XB_SPIN(xb_ld(&bar[XB_TOPGEN]) == tg, bar);
            __builtin_amdgcn_fence(__ATOMIC_ACQUIRE, "agent");
            xb_add(&bar[XB_XGEN(x)], 1u);
            asm volatile("s_waitcnt vmcnt(0)" ::: "memory");
        } else {
            XB_SPIN(xb_ld(&bar[XB_XGEN(x)]) == gen, bar);
            __builtin_amdgcn_fence(__ATOMIC_ACQUIRE, "agent");
            asm volatile("s_waitcnt vmcnt(0)" ::: "memory");
        }
    }
    __syncthreads();
}

namespace pg8 {
constexpr int BM = 256, BK = 64, HALF = 128, HTB = HALF * BK * 2, STAGE_BYTES = 8 * HTB, NXCD = 8, WGM = 8;
__device__ __forceinline__ int lds_byte(int r, int c) { const int st = (r >> 4) * 2 + (c >> 5), rr = r & 15, cc = c & 31, ob = rr * 64 + cc * 2; return st * 1024 + (ob ^ (((ob >> 9) & 1) << 5)); }
__device__ __forceinline__ void stage_rc(int b, int& R, int& C) { const int st = b / 1024, sb = b % 1024, swz = sb ^ (((sb >> 9) & 1) << 5); R = (st >> 1) * 16 + swz / 64; C = (st & 1) * 32 + (swz % 64) / 2; }
__device__ __forceinline__ int perm32(int rho) { const int n = rho >> 4, i = rho & 15; return 8 * (i >> 2) + 4 * n + (i & 3); }
struct Unit { int pm, pn; };
struct Gemm { const bf16_t* A; const bf16_t* Bt; int M, N, K; };
struct StaticOrder {
    int nM, nN, nwg, G, c;
    __device__ void init(int M, int N, int G_, int c_) { nM = M / BM; nN = N / BM; nwg = nM * nN; G = G_; c = c_; }
    __device__ bool next(int i, Unit& u) const {
        const long L = (long)i * G + c; if (L >= nwg) return false;
        int wgid = (int)L; { const int q = nwg / NXCD, r = nwg % NXCD, xcd = wgid % NXCD, off = wgid / NXCD; wgid = (xcd < r ? xcd * (q + 1) : r * (q + 1) + (xcd - r) * q) + off; }
        const int nig = WGM * nN, gid = wgid / nig, fm = gid * WGM, gsz = (nM - fm) < WGM ? (nM - fm) : WGM;
        u.pm = fm + ((wgid % nig) % gsz); u.pn = (wgid % nig) / gsz; return true;
    }
};

template <class Epi>
__device__ __forceinline__ void gemm_phase(LAS unsigned char* lds, const Gemm g, const StaticOrder& S, const Epi& E) {
    const int tid = opq(threadIdx.x), wid = __builtin_amdgcn_readfirstlane(tid >> 6), lane = tid & 63, wr = wid >> 2, wc = wid & 3, fr = lane & 15, fq = lane >> 4;
    const int K = g.K, nt = K / BK;
    unsigned voffA[2], voffB[2];
#pragma unroll
    for (int i = 0; i < 2; ++i) { int R, C; stage_rc(tid * 16 + i * 8192, R, C); const int Rb = (R & ~31) + perm32(R & 31);
        voffA[i] = (unsigned)(R * K + C) * 2u; voffB[i] = (unsigned)(Rb * K + C) * 2u; }
    const size_t kstep = (size_t)(BK * 2);
    const size_t hstep = (size_t)HALF * K * 2;
    const size_t tstep = 2 * hstep;
    const unsigned ldsw = (unsigned)wid * 1024u;
    const int aoff = lds_byte(wr * 64 + fr, fq * 8), boff = lds_byte(wc * 32 + fr, fq * 8);
#define PG8_SA(b, h) (((b) * 2 + (h)) * HTB)
#define PG8_SB(b, h) ((4 + (b) * 2 + (h)) * HTB)
#define PG8_STAGE(bufoff, gbase, voff) do { _Pragma("unroll") for (int _i = 0; _i < 2; ++_i) \
        __builtin_amdgcn_global_load_lds((const unsigned*)((const char*)(gbase) + (voff)[_i]), (LAS unsigned*)(lds + (bufoff) + ldsw + _i * 8192), 16, 0, 0); } while (0)
#define PG8_LDA(dst, b, h) do { _Pragma("unroll") for (int m = 0; m < 4; ++m) _Pragma("unroll") for (int k = 0; k < 2; ++k) dst[m][k] = *(const LAS bf16x8*)(lds + PG8_SA(b, h) + aoff + m * 2048 + k * 1024); } while (0)
#define PG8_LDB(dst, b, h) do { _Pragma("unroll") for (int n = 0; n < 2; ++n) _Pragma("unroll") for (int k = 0; k < 2; ++k) dst[n][k] = *(const LAS bf16x8*)(lds + PG8_SB(b, h) + boff + n * 2048 + k * 1024); } while (0)
#define PG8_MMA(ai, bj, At, Bt) do { __builtin_amdgcn_s_setprio(1); _Pragma("unroll") for (int m = 0; m < 4; ++m) _Pragma("unroll") for (int n = 0; n < 2; ++n) _Pragma("unroll") for (int k = 0; k < 2; ++k) \
        acc[ai][bj][m][n] = __builtin_amdgcn_mfma_f32_16x16x32_bf16(Bt[n][k], At[m][k], acc[ai][bj][m][n], 0, 0, 0); __builtin_amdgcn_s_setprio(0); } while (0)
#define PG8_WAIT_V(n) asm volatile("s_waitcnt vmcnt(" #n ")" ::: "memory")
#define PG8_WAIT_L(n) asm volatile("s_waitcnt lgkmcnt(" #n ")" ::: "memory")
#define PG8_BAR __builtin_amdgcn_s_barrier()
#define PG8_SCHED __builtin_amdgcn_sched_barrier(0)
    Unit cur, nxt; int ui = 0;
    if (!S.next(0, cur)) return;
    f32x4 acc[2][2][4][2];
#pragma unroll
    for (int a = 0; a < 2; ++a)
#pragma unroll
        for (int b = 0; b < 2; ++b)
#pragma unroll
            for (int m = 0; m < 4; ++m)
#pragma unroll
                for (int n = 0; n < 2; ++n) acc[a][b][m][n] = (f32x4){0.f, 0.f, 0.f, 0.f};
    bf16x8 At[4][2], B0[2][2], B1[2][2];
    const char* cA = (const char*)g.A + (size_t)cur.pm * tstep; const char* cB = (const char*)g.Bt + (size_t)cur.pn * tstep;
    PG8_STAGE(PG8_SB(0, 0), cB, voffB); PG8_STAGE(PG8_SA(0, 0), cA, voffA); PG8_STAGE(PG8_SB(0, 1), cB + hstep, voffB); PG8_STAGE(PG8_SA(0, 1), cA + hstep, voffA);
    if (wr == 1) PG8_BAR;
    PG8_WAIT_V(4); PG8_BAR;
    PG8_STAGE(PG8_SB(1, 0), cB + kstep, voffB); PG8_STAGE(PG8_SA(1, 0), cA + kstep, voffA); PG8_STAGE(PG8_SB(1, 1), cB + hstep + kstep, voffB);
    PG8_WAIT_V(6); PG8_BAR;
    for (;;) {
        const bool has_next = S.next(ui + 1, nxt);
        const char* nA = has_next ? (const char*)g.A + (size_t)nxt.pm * tstep : cA; const char* nB = has_next ? (const char*)g.Bt + (size_t)nxt.pn * tstep : cB;
        for (int t = 0; t < nt; t += 2) {
            const bool last = (t == nt - 2);
            const char* a1 = cA + (size_t)(t + 1) * kstep;
            const char* a2 = last ? nA : cA + (size_t)(t + 2) * kstep; const char* b2 = last ? nB : cB + (size_t)(t + 2) * kstep;
            const char* a3 = a2 + kstep; const char* b3 = b2 + kstep;
            PG8_LDB(B0, 0, 0); PG8_SCHED; PG8_LDA(At, 0, 0); PG8_STAGE(PG8_SA(1, 1), a1 + hstep, voffA);
            PG8_WAIT_L(8); PG8_BAR; PG8_WAIT_L(0); PG8_MMA(0, 0, At, B0); PG8_BAR; PG8_SCHED;
            PG8_LDB(B1, 0, 1); PG8_STAGE(PG8_SB(0, 0), b2, voffB);
            PG8_BAR; PG8_WAIT_L(0); PG8_MMA(0, 1, At, B1); PG8_BAR;
            PG8_LDA(At, 0, 1); PG8_STAGE(PG8_SA(0, 0), a2, voffA);
            PG8_BAR; PG8_WAIT_L(0); PG8_MMA(1, 0, At, B0); PG8_BAR; PG8_SCHED;
            PG8_STAGE(PG8_SB(0, 1), b2 + hstep, voffB);
            PG8_WAIT_V(6); PG8_BAR; PG8_MMA(1, 1, At, B1); PG8_BAR;
            PG8_LDB(B0, 1, 0); PG8_SCHED; PG8_LDA(At, 1, 0); PG8_STAGE(PG8_SA(0, 1), a2 + hstep, voffA);
            PG8_WAIT_L(8); PG8_BAR; PG8_WAIT_L(0); PG8_MMA(0, 0, At, B0); PG8_BAR; PG8_SCHED;
            PG8_LDB(B1, 1, 1); PG8_STAGE(PG8_SB(1, 0), b3, voffB);
            PG8_BAR; PG8_WAIT_L(0); PG8_MMA(0, 1, At, B1); PG8_BAR;
            PG8_LDA(At, 1, 1); PG8_STAGE(PG8_SA(1, 0), a3, voffA);
            PG8_BAR; PG8_WAIT_L(0); PG8_MMA(1, 0, At, B0); PG8_BAR; PG8_SCHED;
            PG8_STAGE(PG8_SB(1, 1), b3 + hstep, voffB);
            PG8_WAIT_V(6); PG8_BAR; PG8_MMA(1, 1, At, B1); PG8_BAR;
        }
        E(acc, cur, wr, wc, fr, fq);
        if (!has_next) break;
#pragma unroll
        for (int a = 0; a < 2; ++a)
#pragma unroll
            for (int b = 0; b < 2; ++b)
#pragma unroll
                for (int m = 0; m < 4; ++m)
#pragma unroll
                    for (int n = 0; n < 2; ++n) acc[a][b][m][n] = (f32x4){0.f, 0.f, 0.f, 0.f};
        cur = nxt; cA = nA; cB = nB; ++ui;
    }
    PG8_WAIT_V(0);
    if (wr == 0) PG8_BAR;
    PG8_BAR;
#undef PG8_SA
#undef PG8_SB
#undef PG8_STAGE
#undef PG8_LDA
#undef PG8_LDB
#undef PG8_MMA
#undef PG8_WAIT_V
#undef PG8_WAIT_L
#undef PG8_BAR
#undef PG8_SCHED
}
}
using pg8::Unit;
typedef f32x4 AccT[2][2][4][2];

__device__ __forceinline__ float rstd_of(const float* ss, int r) { return rsqrtf(ss[r] * (1.f / DM) + EPSN); }

struct EpiScIn {
    const float* ss; bf16_t* BG; bf16_t* U; float* out_scp; float* out_scs;
    __device__ __forceinline__ void operator()(const AccT& acc, const Unit& u, int wr, int wc, int fr, int fq) const {
#pragma unroll
        for (int ai = 0; ai < 2; ++ai)
#pragma unroll
            for (int m = 0; m < 4; ++m) {
                const int r = u.pm * 256 + ai * 128 + wr * 64 + m * 16 + fr;
                const float rs = rstd_of(ss, r);
                if (u.pn < 8) {
#pragma unroll
                    for (int bj = 0; bj < 2; ++bj) {
                        const int c = u.pn * 256 + bj * 128 + wc * 32 + 8 * fq;
                        const f32x4 v0 = acc[ai][bj][m][0] * rs, v1 = acc[ai][bj][m][1] * rs;
                        u32x4 w; w.x = pk2(v0[0], v0[1]); w.y = pk2(v0[2], v0[3]); w.z = pk2(v1[0], v1[1]); w.w = pk2(v1[2], v1[3]);
                        *(u32x4*)(BG + (size_t)r * DM + c) = w;
                    }
                } else {
                    const int ch = (u.pn - 8) * 128 + wc * 32 + 8 * fq;
                    const float rs2 = rs * rs;
                    const f32x4 v0 = acc[ai][0][m][0] * acc[ai][1][m][0] * rs2, v1 = acc[ai][0][m][1] * acc[ai][1][m][1] * rs2;
                    u32x4 w; w.x = pk2(v0[0], v0[1]); w.y = pk2(v0[2], v0[3]); w.z = pk2(v1[0], v1[1]); w.w = pk2(v1[2], v1[3]);
                    *(u32x4*)(U + (size_t)r * DM + ch) = w;
                    float* o = nullptr;
                    if (r < NPR) { const int t = r & 2047; if (t >= 2046) o = out_scp + ((size_t)((r >> 11) * 2 + (t - 2046))) * DM + ch; }
                    else { const int rr = r - NPR, t = rr & 7; if (t >= 6) o = out_scs + ((size_t)((rr >> 3) * 2 + (t - 6))) * DM + ch; }
                    if (o) { *(f32x4*)o = v0; *(f32x4*)(o + 4) = v1; }
                }
            }
    }
};
struct EpiPlain {
    bf16_t* O;
    __device__ __forceinline__ void operator()(const AccT& acc, const Unit& u, int wr, int wc, int fr, int fq) const {
#pragma unroll
        for (int ai = 0; ai < 2; ++ai)
#pragma unroll
            for (int m = 0; m < 4; ++m) {
                const int r = u.pm * 256 + ai * 128 + wr * 64 + m * 16 + fr;
#pragma unroll
                for (int bj = 0; bj < 2; ++bj) {
                    const int c = u.pn * 256 + bj * 128 + wc * 32 + 8 * fq;
                    const f32x4 v0 = acc[ai][bj][m][0], v1 = acc[ai][bj][m][1];
                    u32x4 w; w.x = pk2(v0[0], v0[1]); w.y = pk2(v0[2], v0[3]); w.z = pk2(v1[0], v1[1]); w.w = pk2(v1[2], v1[3]);
                    *(u32x4*)(O + (size_t)r * DM + c) = w;
                }
            }
    }
};
template <int MODE> struct EpiRes {
    float* H; bf16_t* HB; float* ss_out; const float* ss_in; const bf16_t* PPl; const float* Hin;
    __device__ __forceinline__ void operator()(const AccT& acc, const Unit& u, int wr, int wc, int fr, int fq) const {
#pragma unroll
        for (int ai = 0; ai < 2; ++ai)
#pragma unroll
            for (int m = 0; m < 4; ++m) {
                const int r = u.pm * 256 + ai * 128 + wr * 64 + m * 16 + fr;
                float rs = 0.f; if (MODE == 1) rs = rstd_of(ss_in, r);
                float sq = 0.f;
#pragma unroll
                for (int bj = 0; bj < 2; ++bj) {
                    const int c = u.pn * 256 + bj * 128 + wc * 32 + 8 * fq;
                    float* hp = H + (size_t)r * DM + c; const float* hi = Hin + (size_t)r * DM + c;
                    f32x4 h0 = *(const f32x4*)hi, h1 = *(const f32x4*)(hi + 4);
                    f32x4 a0 = acc[ai][bj][m][0], a1 = acc[ai][bj][m][1];
                    if (MODE == 1) {
                        const u32x4 pw = *(const u32x4*)(PPl + (size_t)r * DM + c);
                        float pf[8]; unpack8(pw, pf);
#pragma unroll
                        for (int j = 0; j < 4; ++j) { a0[j] = pf[j] * sigmoid_f(a0[j] * rs); a1[j] = pf[4 + j] * sigmoid_f(a1[j] * rs); }
                    }
                    h0 += a0; h1 += a1;
                    *(f32x4*)hp = h0; *(f32x4*)(hp + 4) = h1;
                    u32x4 w; w.x = pk2(h0[0], h0[1]); w.y = pk2(h0[2], h0[3]); w.z = pk2(h1[0], h1[1]); w.w = pk2(h1[2], h1[3]);
                    *(u32x4*)(HB + (size_t)r * DM + c) = w;
                    sq += h0[0] * h0[0] + h0[1] * h0[1] + h0[2] * h0[2] + h0[3] * h0[3] + h1[0] * h1[0] + h1[1] * h1[1] + h1[2] * h1[2] + h1[3] * h1[3];
                }
                sq += __shfl_xor(sq, 16); sq += __shfl_xor(sq, 32);
                if (fq == 0) atomicAdd(ss_out + r, sq);
            }
    }
};
struct EpiGateUp {
    const float* ss; bf16_t* ACT;
    __device__ __forceinline__ void operator()(const AccT& acc, const Unit& u, int wr, int wc, int fr, int fq) const {
#pragma unroll
        for (int ai = 0; ai < 2; ++ai)
#pragma unroll
            for (int m = 0; m < 4; ++m) {
                const int r = u.pm * 256 + ai * 128 + wr * 64 + m * 16 + fr;
                const float rs = rstd_of(ss, r);
                const int ch = u.pn * 128 + wc * 32 + 8 * fq;
                float o[8];
#pragma unroll
                for (int n = 0; n < 2; ++n)
#pragma unroll
                    for (int j = 0; j < 4; ++j) { const float gv = acc[ai][0][m][n][j] * rs, uv = acc[ai][1][m][n][j] * rs; o[4 * n + j] = silu_f(gv) * uv; }
                *(u32x4*)(ACT + (size_t)r * DFF + ch) = pack8(o);
            }
    }
};
struct EpiSsdIn {
    const float* ss; bf16_t* Z; bf16_t* XBC; float* DT; float* out_cp; float* out_cs;
    __device__ __forceinline__ void operator()(const AccT& acc, const Unit& u, int wr, int wc, int fr, int fq) const {
#pragma unroll
        for (int ai = 0; ai < 2; ++ai)
#pragma unroll
            for (int m = 0; m < 4; ++m) {
                const int r = u.pm * 256 + ai * 128 + wr * 64 + m * 16 + fr;
                const float rs = rstd_of(ss, r);
#pragma unroll
                for (int bj = 0; bj < 2; ++bj) {
                    const int c = u.pn * 256 + bj * 128 + wc * 32 + 8 * fq;
                    const f32x4 v0 = acc[ai][bj][m][0] * rs, v1 = acc[ai][bj][m][1] * rs;
                    u32x4 w; w.x = pk2(v0[0], v0[1]); w.y = pk2(v0[2], v0[3]); w.z = pk2(v1[0], v1[1]); w.w = pk2(v1[2], v1[3]);
                    if (u.pn < 16) { *(u32x4*)(Z + (size_t)r * DIN + c) = w; }
                    else if (u.pn < 40) {
                        const int cc = c - DIN;
                        *(u32x4*)(XBC + (size_t)r * CONVD + cc) = w;
                        float* o = nullptr;
                        if (r < NPR) { const int t = r & 2047; if (t >= 2045) o = out_cp + ((size_t)((r >> 11) * 3 + (t - 2045))) * CONVD + cc; }
                        else { const int rr = r - NPR, t = rr & 7; if (t >= 5) o = out_cs + ((size_t)((rr >> 3) * 3 + (t - 5))) * CONVD + cc; }
                        if (o) { *(f32x4*)o = v0; *(f32x4*)(o + 4) = v1; }
                    } else {
                        const int cd = c - (DIN + CONVD);
                        if (cd < 64) { float* o = DT + (size_t)r * 64 + cd; *(f32x4*)o = v0; *(f32x4*)(o + 4) = v1; }
                    }
                }
            }
    }
};


template <int MODE>
__device__ __forceinline__ void small_gemm_res(unsigned char* smem, const bf16_t* A, const bf16_t* Bt, const int K, float* H, const float* Hin, bf16_t* HB, float* ss_out, const float* ss_in, const bf16_t* PPl, const int unit) {
    LAS unsigned char* lds = (LAS unsigned char*)smem;
    const int tid = opq(threadIdx.x), lane = tid & 63, wid = __builtin_amdgcn_readfirstlane(tid >> 6), fr = lane & 15, fq = lane >> 4, wm = wid >> 1, wn = wid & 1;
    const int row0 = (unit & 7) * 128, col0 = (unit >> 3) * 64;
    constexpr int NST = 5, STB = 24576;
    unsigned voffA[2], voffB;
#pragma unroll
    for (int i = 0; i < 2; ++i) { int R, C; pg8::stage_rc(tid * 16 + i * 8192, R, C); voffA[i] = (unsigned)(R * K + C) * 2u; if (i == 0) voffB = (unsigned)(R * K + C) * 2u; }
    const char* gA = (const char*)(A + (size_t)row0 * K); const char* gB = (const char*)(Bt + (size_t)col0 * K);
    const unsigned ldsw = (unsigned)wid * 1024u;
    const int aoff = pg8::lds_byte(wm * 32 + fr, fq * 8), boff = 16384 + pg8::lds_byte(wn * 32 + fr, fq * 8);
    f32x4 acc[2][2];
#pragma unroll
    for (int m = 0; m < 2; ++m)
#pragma unroll
        for (int n = 0; n < 2; ++n) acc[m][n] = (f32x4){0.f, 0.f, 0.f, 0.f};
    const int nt = K >> 6;
#define SG_STAGE(slotoff, t) do { const size_t _ko = (size_t)(t) * 128; \
        __builtin_amdgcn_global_load_lds((const unsigned*)(gA + voffA[0] + _ko), (LAS unsigned*)(lds + (slotoff) + ldsw), 16, 0, 0); \
        __builtin_amdgcn_global_load_lds((const unsigned*)(gA + voffA[1] + _ko), (LAS unsigned*)(lds + (slotoff) + ldsw + 8192), 16, 0, 0); \
        __builtin_amdgcn_global_load_lds((const unsigned*)(gB + voffB + _ko), (LAS unsigned*)(lds + (slotoff) + 16384 + ldsw), 16, 0, 0); } while (0)
    asm volatile("s_waitcnt vmcnt(0)" ::: "memory"); __builtin_amdgcn_s_barrier();
    SG_STAGE(0 * STB, 0); SG_STAGE(1 * STB, 1); SG_STAGE(2 * STB, 2); SG_STAGE(3 * STB, 3);
    int cs = 0, ns = 4 * STB;
#pragma unroll 1
    for (int t = 0; t < nt; ++t) {
        asm volatile("s_waitcnt vmcnt(9)" ::: "memory"); __builtin_amdgcn_s_barrier();
        { const int tn = (t + 4 < nt) ? t + 4 : nt - 1; SG_STAGE(ns, tn); }
#pragma unroll
        for (int kk = 0; kk < 2; ++kk) { bf16x8 af[2], bfr[2];
#pragma unroll
            for (int m = 0; m < 2; ++m) af[m] = *(const LAS bf16x8*)(lds + cs + aoff + m * 2048 + kk * 1024);
#pragma unroll
            for (int n = 0; n < 2; ++n) bfr[n] = *(const LAS bf16x8*)(lds + cs + boff + n * 2048 + kk * 1024);
#pragma unroll
            for (int m = 0; m < 2; ++m)
#pragma unroll
                for (int n = 0; n < 2; ++n) acc[m][n] = __builtin_amdgcn_mfma_f32_16x16x32_bf16(bfr[n], af[m], acc[m][n], 0, 0, 0); }
        cs += STB; if (cs == NST * STB) cs = 0;
        ns += STB; if (ns == NST * STB) ns = 0;
    }
    asm volatile("s_waitcnt vmcnt(0)" ::: "memory"); __builtin_amdgcn_s_barrier();
#undef SG_STAGE
#pragma unroll
    for (int m = 0; m < 2; ++m) {
        const int r = NPR + row0 + wm * 32 + m * 16 + fr;
        float rs = 0.f; if (MODE == 1) rs = rstd_of(ss_in, r);
        float sq = 0.f;
#pragma unroll
        for (int n = 0; n < 2; ++n) {
            const int c = col0 + wn * 32 + n * 16 + 4 * fq;
            float* hp = H + (size_t)r * DM + c;
            f32x4 h0 = *(const f32x4*)(Hin + (size_t)r * DM + c); f32x4 a = acc[m][n];
            if (MODE == 1) { const u32x2 pw = *(const u32x2*)(PPl + (size_t)r * DM + c);
                a[0] = bflo(pw.x) * sigmoid_f(a[0] * rs); a[1] = bfhi(pw.x) * sigmoid_f(a[1] * rs); a[2] = bflo(pw.y) * sigmoid_f(a[2] * rs); a[3] = bfhi(pw.y) * sigmoid_f(a[3] * rs); }
            h0 += a;
            *(f32x4*)hp = h0;
            u32x2 w; w.x = pk2(h0[0], h0[1]); w.y = pk2(h0[2], h0[3]); *(u32x2*)(HB + (size_t)r * DM + c) = w;
            sq += h0[0] * h0[0] + h0[1] * h0[1] + h0[2] * h0[2] + h0[3] * h0[3];
        }
        sq += __shfl_xor(sq, 16); sq += __shfl_xor(sq, 32);
        if (fq == 0) atomicAdd(ss_out + r, sq);
    }
}

struct CvtJob { const float* srcA; const float* srcB; const float* g; bf16_t* dst; int K, ld, nrows, nvalid, mode; };
__device__ __forceinline__ void cvt_item(const CvtJob& J, int item, float* scr, int lane) {
    const int nrb = J.nrows >> 6; const int kb = item / nrb, rb = item - kb * nrb; const int k0 = kb * 64, r0 = rb * 64;
    const float* src; bool valid = true;
    if (J.mode == 0) { src = J.srcA + r0; valid = r0 < J.nvalid; }
    else { const int uu = r0 >> 8, j = r0 & 255; src = (j < 128) ? J.srcA + uu * 128 + j : J.srcB + uu * 128 + (j - 128); }
    const int n2 = (lane & 31) * 2, kr = lane >> 5;
    const float* sp = src + (size_t)(k0 + kr) * J.ld + n2;
    f32x2 v[32];
#pragma unroll
    for (int i = 0; i < 32; ++i) v[i] = valid ? *(const f32x2*)(sp + (size_t)(2 * i) * J.ld) : (f32x2){0.f, 0.f};
    const int c = lane & 7;
    f32x4 g0 = (f32x4){1.f, 1.f, 1.f, 1.f}, g1 = g0;
    if (J.g) { g0 = *(const f32x4*)(J.g + k0 + 8 * c); g1 = *(const f32x4*)(J.g + k0 + 8 * c + 4); }
#pragma unroll
    for (int i = 0; i < 32; ++i) { scr[(2 * i + kr) * 65 + n2] = v[i].x; scr[(2 * i + kr) * 65 + n2 + 1] = v[i].y; }
    LDS_FENCE();
#pragma unroll
    for (int j = 0; j < 8; ++j) { const int n = (lane >> 3) + 8 * j; const float* s = scr + (8 * c) * 65 + n;
        u32x4 o; o.x = pk2(s[0 * 65] * g0[0], s[1 * 65] * g0[1]); o.y = pk2(s[2 * 65] * g0[2], s[3 * 65] * g0[3]); o.z = pk2(s[4 * 65] * g1[0], s[5 * 65] * g1[1]); o.w = pk2(s[6 * 65] * g1[2], s[7 * 65] * g1[3]);
        *(u32x4*)(J.dst + (size_t)(r0 + n) * J.K + k0 + 8 * c) = o; }
    LDS_FENCE();
}
constexpr int NJOBS = 13;
__device__ __forceinline__ CvtJob get_job(const Params& P, int j) {
    CvtJob J; J.srcB = nullptr; J.g = nullptr; J.mode = 0;
    unsigned char* ws = opqp(P.ws);
    switch (j) {
    case 0: J.srcA = P.in[I_SCWIN]; J.g = P.in[I_GMIX]; J.dst = (bf16_t*)(ws + O_W1); J.K = 2048; J.ld = 6144; J.nrows = 2048; J.nvalid = 2048; break;
    case 1: J.srcA = P.in[I_SCWIN] + 2048; J.srcB = P.in[I_SCWIN] + 4096; J.g = P.in[I_GMIX]; J.dst = (bf16_t*)(ws + O_W1) + (size_t)2048 * 2048; J.K = 2048; J.ld = 6144; J.nrows = 4096; J.nvalid = 4096; J.mode = 1; break;
    case 2: J.srcA = P.in[I_SCWOUT]; J.dst = (bf16_t*)(ws + O_W2); J.K = 2048; J.ld = 2048; J.nrows = 2048; J.nvalid = 2048; break;
    case 3: case 4: { const int l = j - 3; J.srcA = P.in[I_WGATE] + (size_t)l * DM * DFF; J.srcB = P.in[I_WUP] + (size_t)l * DM * DFF; J.g = P.in[I_GFFN] + l * DM;
        J.dst = (bf16_t*)(ws + O_W3 + l * SZ_W3); J.K = 2048; J.ld = DFF; J.nrows = 11264; J.nvalid = 11264; J.mode = 1; break; }
    case 5: case 6: { const int l = j - 5; J.srcA = P.in[I_WDOWN] + (size_t)l * DFF * DM; J.dst = (bf16_t*)(ws + O_W4 + l * SZ_W4); J.K = DFF; J.ld = 2048; J.nrows = 2048; J.nvalid = 2048; break; }
    case 7: case 8: { const int l = j - 7; J.srcA = P.in[I_PLEGATE] + (size_t)l * DM * DM; J.g = P.in[I_GPLE] + l * DM; J.dst = (bf16_t*)(ws + O_W5 + l * SZ_W5); J.K = 2048; J.ld = 2048; J.nrows = 2048; J.nvalid = 2048; break; }
    case 9: case 10: { const int l = j - 9; J.srcA = P.in[I_PLEPROJ] + (size_t)l * 256 * DM; J.dst = (bf16_t*)(ws + O_WP + l * SZ_WP); J.K = 256; J.ld = 2048; J.nrows = 2048; J.nvalid = 2048; break; }
    case 11: J.srcA = P.in[I_SSDWIN]; J.g = P.in[I_GMIX] + DM; J.dst = (bf16_t*)(ws + O_W6); J.K = 2048; J.ld = NSSD; J.nrows = NSSDP; J.nvalid = NSSD; break;
    default: J.srcA = P.in[I_SSDWOUT]; J.dst = (bf16_t*)(ws + O_W7); J.K = 4096; J.ld = 2048; J.nrows = 2048; J.nvalid = 2048; break;
    }
    return J;
}
__device__ __forceinline__ int job_items(int j) {
    switch (j) { case 0: return 32 * 32; case 1: return 32 * 64; case 2: return 32 * 32; case 3: case 4: return 32 * 176; case 5: case 6: return 88 * 32;
                 case 7: case 8: return 32 * 32; case 9: case 10: return 4 * 32; case 11: return 32 * 164; default: return 64 * 32; }
}
__device__ __forceinline__ void cvt_jobs(const Params& P, unsigned char* smem, const unsigned mask, const int widx, const int nw) {
    const int tidq = opq(threadIdx.x); const int lane = tidq & 63, wave = tidq >> 6;
    float* scr = (float*)(smem) + wave * (64 * 65);
    int base = 0;
#pragma unroll 1
    for (int j = 0; j < NJOBS; ++j) {
        if (!((mask >> j) & 1u)) continue;
        const CvtJob J = get_job(P, j); const int ni = job_items(j);
        int first = (widx - (base % nw) + nw) % nw;
        for (int it = first; it < ni; it += nw) cvt_item(J, it, scr, lane);
        base += ni;
    }
}
__device__ __forceinline__ void phase0(const Params& P, unsigned char* smem) {
    const int tid = opq(threadIdx.x), lane = tid & 63, wave = tid >> 6;
    const int gw = blockIdx.x * 8 + wave, NGW = 2048;
    unsigned char* ws = opqp(P.ws);
    float* H = (float*)(ws + O_H); bf16_t* HB = (bf16_t*)(ws + O_HB); float* SS = (float*)(ws + O_SS);
    for (int r = gw; r < NTOK; r += NGW) {
        const float* xr = (r < NPR) ? P.in[I_XP] + (size_t)r * DM : P.in[I_XS] + (size_t)(r - NPR) * DM;
        float s = 0.f;
#pragma unroll
        for (int j = 0; j < 8; ++j) { const int c = (j * 64 + lane) * 4; const f32x4 v = *(const f32x4*)(xr + c);
            u32x2 w; w.x = pk2(v[0], v[1]); w.y = pk2(v[2], v[3]); *(u32x2*)(HB + (size_t)r * DM + c) = w;
            s += v[0] * v[0] + v[1] * v[1] + v[2] * v[2] + v[3] * v[3]; }
        s = wave_sum(s);
        if (lane == 0) SS[r] = s;
    }
    const int gt = blockIdx.x * 512 + tid, NGT = 131072;
    for (int i = gt; i < 6 * NTOK; i += NGT) SS[NTOK + i] = 0.f;
    bf16_t* PB = (bf16_t*)(ws + O_PB);
    for (int i0 = gt; i0 < 2 * NTOK * 64; i0 += 3 * NGT) {
        f32x4 v[3]; size_t dsto[3];
#pragma unroll
        for (int u = 0; u < 3; ++u) {
            const int i = i0 + u * NGT;
            const int l = i / (NTOK * 64), rem = i - l * (NTOK * 64), r = rem >> 6, c = (rem & 63) * 4;
            const float* src = (r < NPR) ? P.in[I_PP] + ((size_t)l * NPR + r) * 256 + c : P.in[I_PS] + ((size_t)l * 1024 + (r - NPR)) * 256 + c;
            v[u] = *(const f32x4*)src; dsto[u] = ((size_t)l * NTOK + r) * 256 + c;
        }
#pragma unroll
        for (int u = 0; u < 3; ++u) { u32x2 w; w.x = pk2(v[u][0], v[u][1]); w.y = pk2(v[u][2], v[u][3]); *(u32x2*)(PB + dsto[u]) = w; }
    }
    cvt_jobs(P, smem, 0x60F, gw, NGW);
}

__device__ __forceinline__ void sc_conv_phase(const Params& P) {
    unsigned char* ws = opqp(P.ws); bf16_t* BG = (bf16_t*)(ws + O_BG); const bf16_t* U = (const bf16_t*)(ws + O_U);
    const float* wc = P.in[I_SCWCONV]; const float* buf = P.in[I_SSC];
    const int gt = opq(threadIdx.x) + blockIdx.x * 512, NGT = 131072;
    for (int i = gt; i < (NTOK / 4) * 256; i += NGT) {
        const int rb = i >> 8, ch = (i & 255) * 8, r0 = rb * 4;
        float w0[8], w1[8], w2[8];
#pragma unroll
        for (int e = 0; e < 8; e += 4) { *(f32x4*)(w0 + e) = *(const f32x4*)(wc + ch + e); *(f32x4*)(w1 + e) = *(const f32x4*)(wc + DM + ch + e); *(f32x4*)(w2 + e) = *(const f32x4*)(wc + 2 * DM + ch + e); }
        float um2[8], um1[8];
        const bool pr = r0 < NPR; const int t0 = pr ? (r0 & 2047) : ((r0 - NPR) & 7);
        if (t0 == 0) {
            if (pr) {
#pragma unroll
                for (int e = 0; e < 8; ++e) { um2[e] = 0.f; um1[e] = 0.f; }
            } else { const int b = (r0 - NPR) >> 3;
#pragma unroll
                for (int e = 0; e < 8; e += 4) { *(f32x4*)(um2 + e) = *(const f32x4*)(buf + ((size_t)b * 2 + 0) * DM + ch + e); *(f32x4*)(um1 + e) = *(const f32x4*)(buf + ((size_t)b * 2 + 1) * DM + ch + e); } }
        } else {
            unpack8(*(const u32x4*)(U + (size_t)(r0 - 2) * DM + ch), um2); unpack8(*(const u32x4*)(U + (size_t)(r0 - 1) * DM + ch), um1);
        }
#pragma unroll
        for (int j = 0; j < 4; ++j) {
            float uc[8], bg[8], o[8];
            unpack8(*(const u32x4*)(U + (size_t)(r0 + j) * DM + ch), uc); unpack8(*(const u32x4*)(BG + (size_t)(r0 + j) * DM + ch), bg);
#pragma unroll
            for (int e = 0; e < 8; ++e) { o[e] = bg[e] * (w0[e] * um2[e] + w1[e] * um1[e] + w2[e] * uc[e]); um2[e] = um1[e]; um1[e] = uc[e]; }
            *(u32x4*)(BG + (size_t)(r0 + j) * DM + ch) = pack8(o);
        }
    }
}

constexpr int LST = 136;
__device__ __forceinline__ bf16x8 lds_frag(const bf16_t* base, int row, int col) { return *(const bf16x8*)(base + row * LST + col); }

__device__ __forceinline__ void ssd_prompt_item(const Params& P, int item, unsigned char* smem) {
    const int tid = opq(threadIdx.x), lane = tid & 63, wid = tid >> 6, fr = lane & 15, fq = lane >> 4;
    const int g = item & 7, c = (item >> 3) & 15, b = item >> 7;
    const int row0 = b * 2048 + c * 128;
    unsigned char* ws = opqp(P.ws);
    const bf16_t* XBC = (const bf16_t*)(ws + O_XBC); const float* DT = (const float*)(ws + O_DT);
    bf16_t* CC = (bf16_t*)(ws + O_CC); bf16_t* XS = (bf16_t*)(ws + O_XS); bf16_t* Y = (bf16_t*)(ws + O_Y); float* SC = (float*)(ws + O_SC); float* ACUM = (float*)(ws + O_ACUM);
    const float* cw = P.in[I_SSDCONVW]; const float* cb = P.in[I_SSDCONVB];
    bf16_t* Cs = (bf16_t*)(smem); bf16_t* Bs = (bf16_t*)(smem + 34816); bf16_t* BTs = (bf16_t*)(smem + 2 * 34816); bf16_t* CBs = (bf16_t*)(smem + 3 * 34816);
    bf16_t* XT = Cs; bf16_t* XD = (bf16_t*)(smem + 17408);
    float* acs_all = (float*)(smem + 4 * 34816); float* dts_all = acs_all + 1024; float* wts = dts_all + 1024;
    {
        const int h = g * 8 + wid;
        const float A = -__expf(P.in[I_ALOG][h]); const float db = P.in[I_DTB][h];
        const float d0 = softplus_f(DT[(size_t)(row0 + 2 * lane) * 64 + h] + db), d1 = softplus_f(DT[(size_t)(row0 + 2 * lane + 1) * 64 + h] + db);
        const float a0 = d0 * A, a1 = d1 * A; float s = a0 + a1;
#pragma unroll
        for (int o = 1; o < 64; o <<= 1) { const float v = __shfl_up(s, o); if (lane >= o) s += v; }
        acs_all[wid * 128 + 2 * lane] = s - a1; acs_all[wid * 128 + 2 * lane + 1] = s; dts_all[wid * 128 + 2 * lane] = d0; dts_all[wid * 128 + 2 * lane + 1] = d1;
        f32x2 av; av.x = s - a1; av.y = s;
        *(f32x2*)(ACUM + ((size_t)(b * 64 + h)) * 2048 + c * 128 + 2 * lane) = av;
#pragma unroll
        for (int k = 0; k < 4; ++k) wts[k * 512 + tid] = cw[(size_t)k * CONVD + g * 512 + tid];
        wts[4 * 512 + tid] = cb[g * 512 + tid];
    }
    {
        const int n0 = (tid & 15) * 8, r = tid >> 4;
#pragma unroll 1
        for (int mat = 0; mat < 2; ++mat) {
            const int ch = DIN + mat * 1024 + g * 128 + n0;
            float w[4][8], bias[8];
#pragma unroll
            for (int k = 0; k < 4; ++k) { *(f32x4*)(w[k]) = *(const f32x4*)(cw + (size_t)k * CONVD + ch); *(f32x4*)(w[k] + 4) = *(const f32x4*)(cw + (size_t)k * CONVD + ch + 4); }
            *(f32x4*)(bias) = *(const f32x4*)(cb + ch); *(f32x4*)(bias + 4) = *(const f32x4*)(cb + ch + 4);
            u32x4 xr[7];
#pragma unroll
            for (int j = 0; j < 7; ++j) { const int t = 4 * r - 3 + j; const bool ok = (c > 0) || (t >= 0);
                xr[j] = ok ? *(const u32x4*)(XBC + (size_t)(row0 + t) * CONVD + ch) : (u32x4){0u, 0u, 0u, 0u}; }
            float o[4][8];
#pragma unroll
            for (int i = 0; i < 4; ++i) {
                float x0[8], x1[8], x2[8], x3[8]; unpack8(xr[i], x0); unpack8(xr[i + 1], x1); unpack8(xr[i + 2], x2); unpack8(xr[i + 3], x3);
#pragma unroll
                for (int e = 0; e < 8; ++e) o[i][e] = silu_f(w[0][e] * x0[e] + w[1][e] * x1[e] + w[2][e] * x2[e] + w[3][e] * x3[e] + bias[e]);
            }
            if (mat == 0) {
#pragma unroll
                for (int i = 0; i < 4; ++i) *(u32x4*)(Bs + (4 * r + i) * LST + n0) = pack8(o[i]);
#pragma unroll
                for (int e = 0; e < 8; ++e) { u32x2 w2; w2.x = pk2(o[0][e], o[1][e]); w2.y = pk2(o[2][e], o[3][e]); *(u32x2*)(BTs + (n0 + e) * LST + 4 * r) = w2; }
            } else {
#pragma unroll
                for (int i = 0; i < 4; ++i) { const u32x4 pw = pack8(o[i]); *(u32x4*)(Cs + (4 * r + i) * LST + n0) = pw; *(u32x4*)(CC + (size_t)(row0 + 4 * r + i) * 1024 + g * 128 + n0) = pw; }
            }
        }
    }
    const int p0 = (tid & 7) * 8, xr_r = tid >> 3;
    u32x4 xr[5];
#pragma unroll
    for (int j = 0; j < 5; ++j) { const int t = 2 * xr_r - 3 + j; const bool ok = (c > 0) || (t >= 0);
        xr[j] = ok ? *(const u32x4*)(XBC + (size_t)(row0 + t) * CONVD + (g * 8) * 64 + p0) : (u32x4){0u, 0u, 0u, 0u}; }
    LDS_BARRIER();
    {
        f32x4 acc[8];
#pragma unroll
        for (int j = 0; j < 8; ++j) acc[j] = (f32x4){0.f, 0.f, 0.f, 0.f};
#pragma unroll
        for (int kk = 0; kk < 4; ++kk) {
            const bf16x8 a = lds_frag(Cs, 16 * wid + fr, 32 * kk + 8 * fq);
#pragma unroll
            for (int j = 0; j < 8; ++j) if (j <= wid) { const bf16x8 bb = lds_frag(Bs, 16 * j + fr, 32 * kk + 8 * fq); acc[j] = __builtin_amdgcn_mfma_f32_16x16x32_bf16(bb, a, acc[j], 0, 0, 0); }
        }
#pragma unroll
        for (int j = 0; j < 8; ++j) if (j <= wid) { u32x2 w2; w2.x = pk2(acc[j][0], acc[j][1]); w2.y = pk2(acc[j][2], acc[j][3]); *(u32x2*)(CBs + (16 * wid + fr) * LST + 16 * j + 4 * fq) = w2; }
    }
    LDS_BARRIER();
#pragma unroll 1
    for (int hh = 0; hh < 8; ++hh) {
        const int h = g * 8 + hh;
        const float* acs = acs_all + hh * 128; const float* dts = dts_all + hh * 128;
        {
            const int r = xr_r; const int ch = h * 64 + p0;
            float o[2][8];
            {
                float w[4][8], bias[8];
#pragma unroll
                for (int k = 0; k < 4; ++k) { *(f32x4*)(w[k]) = *(const f32x4*)(wts + k * 512 + hh * 64 + p0); *(f32x4*)(w[k] + 4) = *(const f32x4*)(wts + k * 512 + hh * 64 + p0 + 4); }
                *(f32x4*)(bias) = *(const f32x4*)(wts + 4 * 512 + hh * 64 + p0); *(f32x4*)(bias + 4) = *(const f32x4*)(wts + 4 * 512 + hh * 64 + p0 + 4);
#pragma unroll
                for (int i = 0; i < 2; ++i) {
                    float x0[8], x1[8], x2[8], x3[8]; unpack8(xr[i], x0); unpack8(xr[i + 1], x1); unpack8(xr[i + 2], x2); unpack8(xr[i + 3], x3);
#pragma unroll
                    for (int e = 0; e < 8; ++e) o[i][e] = silu_f(w[0][e] * x0[e] + w[1][e] * x1[e] + w[2][e] * x2[e] + w[3][e] * x3[e] + bias[e]);
                }
            }
            if (hh < 7) {
#pragma unroll
                for (int j = 0; j < 5; ++j) { const int t = 2 * r - 3 + j; const bool ok = (c > 0) || (t >= 0);
                    xr[j] = ok ? *(const u32x4*)(XBC + (size_t)(row0 + t) * CONVD + (h + 1) * 64 + p0) : (u32x4){0u, 0u, 0u, 0u}; }
            }
            const float aend = acs[127];
            const float d0 = dts[2 * r], d1 = dts[2 * r + 1];
            const float e0 = d0 * __expf(aend - acs[2 * r]), e1 = d1 * __expf(aend - acs[2 * r + 1]);
#pragma unroll
            for (int e = 0; e < 8; ++e) {
                *(unsigned*)(XT + (p0 + e) * LST + 2 * r) = pk2(o[0][e] * d0, o[1][e] * d1);
                *(unsigned*)(XD + (p0 + e) * LST + 2 * r) = pk2(o[0][e] * e0, o[1][e] * e1);
            }
        }
        LDS_BARRIER();
        {
            const int t = 16 * wid + fr; const float at = acs[t];
            const float dsk = P.in[I_SSDD][h] * __builtin_amdgcn_rcpf(fmaxf(dts[t], 1e-30f));
            f32x4 acc[4];
#pragma unroll
            for (int j = 0; j < 4; ++j) acc[j] = (f32x4){0.f, 0.f, 0.f, 0.f};
#pragma unroll
            for (int kk = 0; kk < 4; ++kk) if (32 * kk <= 16 * wid + 15) {
                const int s0 = 32 * kk + 8 * fq;
                float cbv[8]; unpack8(*(const u32x4*)(CBs + t * LST + s0), cbv);
                float as[8]; *(f32x4*)(as) = *(const f32x4*)(acs + s0); *(f32x4*)(as + 4) = *(const f32x4*)(acs + s0 + 4);
                float mv[8];
#pragma unroll
                for (int e = 0; e < 8; ++e) mv[e] = (s0 + e < t) ? cbv[e] * __expf(at - as[e]) : ((s0 + e == t) ? cbv[e] + dsk : 0.f);
                const u32x4 mp = pack8(mv); const bf16x8 a = *(const bf16x8*)&mp;
#pragma unroll
                for (int j = 0; j < 4; ++j) { const bf16x8 bb = lds_frag(XT, 16 * j + fr, 32 * kk + 8 * fq); acc[j] = __builtin_amdgcn_mfma_f32_16x16x32_bf16(bb, a, acc[j], 0, 0, 0); }
            }
#pragma unroll
            for (int j = 0; j < 4; ++j) { u32x2 w2; w2.x = pk2(acc[j][0], acc[j][1]); w2.y = pk2(acc[j][2], acc[j][3]);
                *(u32x2*)(Y + (size_t)(row0 + t) * DIN + h * 64 + 16 * j + 4 * fq) = w2; }
        }
        {
            f32x4 acc[4];
#pragma unroll
            for (int j = 0; j < 4; ++j) acc[j] = (f32x4){0.f, 0.f, 0.f, 0.f};
#pragma unroll
            for (int kk = 0; kk < 4; ++kk) {
                const bf16x8 xb = lds_frag(BTs, 16 * wid + fr, 32 * kk + 8 * fq);
#pragma unroll
                for (int j = 0; j < 4; ++j) { const bf16x8 yb = lds_frag(XD, 16 * j + fr, 32 * kk + 8 * fq); acc[j] = __builtin_amdgcn_mfma_f32_16x16x32_bf16(xb, yb, acc[j], 0, 0, 0); }
            }
            bf16_t* scb = (bf16_t*)SC + ((size_t)((b * 16 + c) * 64 + h)) * 64 * 128;
#pragma unroll
            for (int j = 0; j < 4; ++j) { u32x2 w2; w2.x = pk2(acc[j][0], acc[j][1]); w2.y = pk2(acc[j][2], acc[j][3]); *(u32x2*)(scb + (size_t)(16 * j + fr) * 128 + 16 * wid + 4 * fq) = w2; }
        }
        LDS_BARRIER();
    }
}

__device__ __forceinline__ void ssd_sample_item(const Params& P, int item, unsigned char* smem) {
    const int tid = opq(threadIdx.x), lane = tid & 63, wid = tid >> 6, fr = lane & 15, fq = lane >> 4;
    const int g = item & 7, b = item >> 3, h = g * 8 + wid;
    const int R0 = NPR + b * 8;
    unsigned char* ws = opqp(P.ws);
    const bf16_t* XBC = (const bf16_t*)(ws + O_XBC); const float* DT = (const float*)(ws + O_DT); bf16_t* Y = (bf16_t*)(ws + O_Y);
    const float* cw = P.in[I_SSDCONVW]; const float* cbias = P.in[I_SSDCONVB]; const float* cbuf = P.in[I_SSDC] + (size_t)b * 3 * CONVD;
    const float* st_in = P.in[I_SSD] + ((size_t)(b * 64 + h)) * 64 * 128; float* st_out = P.out + OO_SSDS + ((size_t)(b * 64 + h)) * 64 * 128;
    float* Bsm = (float*)smem;
    float* Csm = Bsm + 1024;
    float* cbs = Csm + 1024;
    float* yis = cbs + 64 + wid * 512;
    bf16_t* C16 = (bf16_t*)(smem + 24832);
    bf16_t* BT16 = C16 + 1024;
    bf16_t* xw16 = BT16 + 1024 + wid * 512;
    LDS_BARRIER();
    {
        const int mat = tid >> 8, t = (tid >> 5) & 7, n4 = (tid & 31) * 4;
        const int ch = DIN + mat * 1024 + g * 128 + n4;
        f32x4 accv = *(const f32x4*)(cbias + ch);
#pragma unroll
        for (int k = 0; k < 4; ++k) {
            const int j = t + k; f32x4 xv;
            if (j < 3) xv = *(const f32x4*)(cbuf + (size_t)j * CONVD + ch);
            else { const u32x2 pw = *(const u32x2*)(XBC + (size_t)(R0 + j - 3) * CONVD + ch); xv = (f32x4){bflo(pw.x), bfhi(pw.x), bflo(pw.y), bfhi(pw.y)}; }
            accv += *(const f32x4*)(cw + (size_t)k * CONVD + ch) * xv;
        }
        f32x4 o; o[0] = silu_f(accv[0]); o[1] = silu_f(accv[1]); o[2] = silu_f(accv[2]); o[3] = silu_f(accv[3]);
        *(f32x4*)((mat ? Csm : Bsm) + t * 128 + n4) = o;
        const unsigned p01 = pk2(o[0], o[1]), p23 = pk2(o[2], o[3]);
        if (mat) { u32x2 w2; w2.x = p01; w2.y = p23; *(u32x2*)(C16 + t * 128 + n4) = w2; }
        else { BT16[(n4 + 0) * 8 + t] = (bf16_t)(p01 & 0xffffu); BT16[(n4 + 1) * 8 + t] = (bf16_t)(p01 >> 16); BT16[(n4 + 2) * 8 + t] = (bf16_t)(p23 & 0xffffu); BT16[(n4 + 3) * 8 + t] = (bf16_t)(p23 >> 16); }
    }
    float xs[8], dtv[8], ac[8];
    {
        const int ch = h * 64 + lane;
        float up[11];
#pragma unroll
        for (int j = 0; j < 3; ++j) up[j] = cbuf[(size_t)j * CONVD + ch];
#pragma unroll
        for (int j = 0; j < 8; ++j) up[3 + j] = __uint_as_float((unsigned)XBC[(size_t)(R0 + j) * CONVD + ch] << 16);
        const float w0 = cw[ch], w1 = cw[CONVD + ch], w2 = cw[2 * CONVD + ch], w3 = cw[3 * CONVD + ch], bs = cbias[ch];
#pragma unroll
        for (int t = 0; t < 8; ++t) xs[t] = silu_f(w0 * up[t] + w1 * up[t + 1] + w2 * up[t + 2] + w3 * up[t + 3] + bs);
        const float A = -__expf(P.in[I_ALOG][h]); const float db = P.in[I_DTB][h];
        float run = 0.f;
#pragma unroll
        for (int t = 0; t < 8; ++t) { dtv[t] = softplus_f(DT[(size_t)(R0 + t) * 64 + h] + db); run += dtv[t] * A; ac[t] = run; }
    }
    {
        float v[8];
#pragma unroll
        for (int s = 0; s < 8; ++s) v[s] = __expf(ac[7] - ac[s]) * dtv[s] * xs[s];
        *(u32x4*)(xw16 + lane * 8) = pack8(v);
    }
    LDS_BARRIER();
    {
        const int s = lane & 7, part = lane >> 3;
        float d = 0.f;
#pragma unroll
        for (int n = 0; n < 16; ++n) d += Csm[wid * 128 + part * 16 + n] * Bsm[s * 128 + part * 16 + n];
        d += __shfl_xor(d, 8); d += __shfl_xor(d, 16); d += __shfl_xor(d, 32);
        if (lane < 8) cbs[wid * 8 + lane] = d;
    }
    {
        const float ee = __expf(ac[7]);
        const bf16x8 zero8 = (bf16x8){0, 0, 0, 0, 0, 0, 0, 0};
        bf16x8 cfrag[4], btf[8];
#pragma unroll
        for (int kk = 0; kk < 4; ++kk) cfrag[kk] = (fr < 8) ? *(const bf16x8*)(C16 + fr * 128 + 32 * kk + 8 * fq) : zero8;
#pragma unroll
        for (int nt = 0; nt < 8; ++nt) btf[nt] = (fq == 0) ? *(const bf16x8*)(BT16 + (16 * nt + fr) * 8) : zero8;
#pragma unroll
        for (int j = 0; j < 4; ++j) {
            const float* hp = st_in + (size_t)(16 * j + fr) * 128;
            f32x4 hb[4][2], hc[8];
#pragma unroll
            for (int kk = 0; kk < 4; ++kk) { hb[kk][0] = *(const f32x4*)(hp + 32 * kk + 8 * fq); hb[kk][1] = *(const f32x4*)(hp + 32 * kk + 8 * fq + 4); }
#pragma unroll
            for (int nt = 0; nt < 8; ++nt) hc[nt] = *(const f32x4*)(hp + 16 * nt + 4 * fq);
            f32x4 ya = (f32x4){0.f, 0.f, 0.f, 0.f};
#pragma unroll
            for (int kk = 0; kk < 4; ++kk) {
                u32x4 hw; hw.x = pk2(hb[kk][0][0], hb[kk][0][1]); hw.y = pk2(hb[kk][0][2], hb[kk][0][3]); hw.z = pk2(hb[kk][1][0], hb[kk][1][1]); hw.w = pk2(hb[kk][1][2], hb[kk][1][3]);
                ya = __builtin_amdgcn_mfma_f32_16x16x32_bf16(cfrag[kk], *(const bf16x8*)&hw, ya, 0, 0, 0);
            }
            if (fq < 2) {
#pragma unroll
                for (int jj = 0; jj < 4; ++jj) yis[(4 * fq + jj) * 64 + 16 * j + fr] = ya[jj];
            }
            const bf16x8 xf = (fq == 0) ? *(const bf16x8*)(xw16 + (16 * j + fr) * 8) : zero8;
            float* op = st_out + (size_t)(16 * j + fr) * 128;
#pragma unroll
            for (int nt = 0; nt < 8; ++nt) {
                const f32x4 d = __builtin_amdgcn_mfma_f32_16x16x32_bf16(btf[nt], xf, hc[nt] * ee, 0, 0, 0);
                *(f32x4*)(op + 16 * nt + 4 * fq) = d;
            }
        }
    }
    LDS_BARRIER();
#pragma unroll
    for (int t = 0; t < 8; ++t) {
        float a = 0.f;
#pragma unroll
        for (int s = 0; s <= t; ++s) a += cbs[t * 8 + s] * __expf(ac[t] - ac[s]) * dtv[s] * xs[s];
        const float y = a + P.in[I_SSDD][h] * xs[t] + __expf(ac[t]) * yis[t * 64 + lane];
        Y[(size_t)(R0 + t) * DIN + h * 64 + lane] = (bf16_t)(pk2(y, 0.f) & 0xffffu);
    }
}

__device__ __forceinline__ void ssd_scan_item(const Params& P, int item, unsigned char* smem) {
    const int tid = opq(threadIdx.x), lane = tid & 63, wid = tid >> 6, fr = lane & 15, fq = lane >> 4;
    const int b = item >> 6, h = item & 63, g = h >> 3;
    unsigned char* ws = opqp(P.ws);
    const bf16_t* CC = (const bf16_t*)(ws + O_CC); const bf16_t* XS = (const bf16_t*)(ws + O_XS); bf16_t* Y = (bf16_t*)(ws + O_Y);
    const float* SC = (const float*)(ws + O_SC); const float* ACUM = (const float*)(ws + O_ACUM);
    bf16_t* Cs = (bf16_t*)smem; bf16_t* Hs = (bf16_t*)(smem + 34816); float* acs = (float*)(smem + 34816 + 17408);
    const int n4 = (tid & 31) * 4, pb = tid >> 5;
    const int t = 16 * wid + fr;
    f32x4 st[4];
#pragma unroll
    for (int i = 0; i < 4; ++i) st[i] = (f32x4){0.f, 0.f, 0.f, 0.f};
    u32x4 cpf[4]; float acv = 0.f; u32x2 ywn[4]; u32x2 scn[4];
#define SCAN_PREFETCH(cn) do { const int _row0 = b * 2048 + (cn) * 128; \
        _Pragma("unroll") for (int i = 0; i < 4; ++i) { const int piece = tid + 512 * i, r = piece >> 4, q = piece & 15; cpf[i] = *(const u32x4*)(CC + (size_t)(_row0 + r) * 1024 + g * 128 + q * 8); } \
        if (tid < 128) acv = ACUM[((size_t)(b * 64 + h)) * 2048 + (cn) * 128 + tid]; \
        _Pragma("unroll") for (int j = 0; j < 4; ++j) { const size_t idx = (size_t)(_row0 + t) * DIN + h * 64 + 16 * j + 4 * fq; ywn[j] = *(const u32x2*)(Y + idx); } \
        { const bf16_t* scb = (const bf16_t*)SC + ((size_t)((b * 16 + (cn)) * 64 + h)) * 64 * 128; \
          _Pragma("unroll") for (int i = 0; i < 4; ++i) scn[i] = *(const u32x2*)(scb + (size_t)(pb + 16 * i) * 128 + n4); } } while (0)
    SCAN_PREFETCH(0);
    LDS_BARRIER();
#pragma unroll 1
    for (int c = 0; c < 16; ++c) {
        const int row0 = b * 2048 + c * 128;
#pragma unroll
        for (int i = 0; i < 4; ++i) { const int piece = tid + 512 * i, r = piece >> 4, q = piece & 15; *(u32x4*)(Cs + r * LST + q * 8) = cpf[i]; }
        if (tid < 128) acs[tid] = acv;
#pragma unroll
        for (int i = 0; i < 4; ++i) { u32x2 w2; w2.x = pk2(st[i][0], st[i][1]); w2.y = pk2(st[i][2], st[i][3]); *(u32x2*)(Hs + (pb + 16 * i) * LST + n4) = w2; }
        u32x2 yw[4]; u32x2 scv[4];
#pragma unroll
        for (int j = 0; j < 4; ++j) { yw[j] = ywn[j]; scv[j] = scn[j]; }
        LDS_BARRIER();
        if (c < 15) SCAN_PREFETCH(c + 1);
        {
            f32x4 acc[4];
#pragma unroll
            for (int j = 0; j < 4; ++j) acc[j] = (f32x4){0.f, 0.f, 0.f, 0.f};
#pragma unroll
            for (int kk = 0; kk < 4; ++kk) {
                const bf16x8 a = lds_frag(Cs, 16 * wid + fr, 32 * kk + 8 * fq);
#pragma unroll
                for (int j = 0; j < 4; ++j) { const bf16x8 bb = lds_frag(Hs, 16 * j + fr, 32 * kk + 8 * fq); acc[j] = __builtin_amdgcn_mfma_f32_16x16x32_bf16(bb, a, acc[j], 0, 0, 0); }
            }
            const float et = __expf(acs[t]);
#pragma unroll
            for (int j = 0; j < 4; ++j) {
                const size_t idx = (size_t)(row0 + t) * DIN + h * 64 + 16 * j + 4 * fq;
                const float y0 = bflo(yw[j].x) + et * acc[j][0], y1 = bfhi(yw[j].x) + et * acc[j][1];
                const float y2 = bflo(yw[j].y) + et * acc[j][2], y3 = bfhi(yw[j].y) + et * acc[j][3];
                u32x2 o; o.x = pk2(y0, y1); o.y = pk2(y2, y3); *(u32x2*)(Y + idx) = o;
            }
        }
        {
            const float ec = __expf(acs[127]);
#pragma unroll
            for (int i = 0; i < 4; ++i) st[i] = st[i] * ec + (f32x4){bflo(scv[i].x), bfhi(scv[i].x), bflo(scv[i].y), bfhi(scv[i].y)};
        }
        LDS_BARRIER();
    }
#undef SCAN_PREFETCH
    float* so = P.out + OO_SSDP + ((size_t)(b * 64 + h)) * 64 * 128;
#pragma unroll
    for (int i = 0; i < 4; ++i) *(f32x4*)(so + (size_t)(pb + 16 * i) * 128 + n4) = st[i];
}

__device__ __forceinline__ void ssd_gate_phase(const Params& P) {
    unsigned char* ws = opqp(P.ws); const bf16_t* Y = (const bf16_t*)(ws + O_Y); const bf16_t* Z = (const bf16_t*)(ws + O_Z); bf16_t* A7 = (bf16_t*)(ws + O_A7);
    const float* ng = P.in[I_NORMG];
    const int tidq = opq(threadIdx.x); const int lane = tidq & 63, gw = blockIdx.x * 8 + (tidq >> 6), NGW = 2048;
    for (int it0 = gw * 4; it0 < NTOK * 8; it0 += NGW * 4) {
        u32x4 yv[4], zv[4];
#pragma unroll
        for (int u = 0; u < 4; ++u) { const int it = it0 + u; const size_t idx = (size_t)(it >> 3) * DIN + (it & 7) * 512 + lane * 8; yv[u] = *(const u32x4*)(Y + idx); zv[u] = *(const u32x4*)(Z + idx); }
#pragma unroll
        for (int u = 0; u < 4; ++u) {
            const int it = it0 + u; const int g = it & 7; const size_t idx = (size_t)(it >> 3) * DIN + g * 512 + lane * 8;
            float y[8], z[8], gt[8]; unpack8(yv[u], y); unpack8(zv[u], z);
            float sacc = 0.f;
#pragma unroll
            for (int e = 0; e < 8; ++e) { gt[e] = y[e] * silu_f(z[e]); sacc += gt[e] * gt[e]; }
            sacc = wave_sum(sacc);
            const float sc = rsqrtf(sacc * (1.f / 512.f) + EPSN);
            float gn[8]; *(f32x4*)(gn) = *(const f32x4*)(ng + g * 512 + lane * 8); *(f32x4*)(gn + 4) = *(const f32x4*)(ng + g * 512 + lane * 8 + 4);
#pragma unroll
            for (int e = 0; e < 8; ++e) gt[e] = gt[e] * sc * gn[e];
            *(u32x4*)(A7 + idx) = pack8(gt);
        }
    }
}

__device__ __forceinline__ void final_phase(const Params& P) {
    unsigned char* ws = opqp(P.ws); const float* H = (const float*)(ws + O_H); const float* SS = (const float*)(ws + O_SS) + 6 * NTOK; const float* gf = P.in[I_GFIN];
    const int tidq = opq(threadIdx.x); const int lane = tidq & 63, gw = blockIdx.x * 8 + (tidq >> 6), NGW = 2048;
    for (int r = gw; r < NTOK; r += NGW) {
        const float rs = rstd_of(SS, r);
#pragma unroll
        for (int j = 0; j < 8; ++j) { const int c = (j * 64 + lane) * 4; const f32x4 v = *(const f32x4*)(H + (size_t)r * DM + c); const f32x4 gv = *(const f32x4*)(gf + c);
            *(f32x4*)(P.out + OO_Y + (size_t)r * DM + c) = v * rs * gv; }
    }
}

__global__ void __launch_bounds__(512, 2) hybrid_mega(Params P) {
    extern __shared__ __attribute__((aligned(16))) unsigned char smem[];
    cg::grid_group grid = cg::this_grid();
    LAS unsigned char* lds = (LAS unsigned char*)smem;
    unsigned char* ws = opqp(P.ws);
    float* SS = (float*)(ws + O_SS); float* H = (float*)(ws + O_H);
    bf16_t* HB0 = (bf16_t*)(ws + O_HB); bf16_t* HB1 = (bf16_t*)(ws + O_PP);
    constexpr int G = 256;
    const int c = (int)blockIdx.x;
    pg8::StaticOrder S;

    unsigned* bar = (unsigned*)(ws + O_BAR); volatile LAS unsigned* bst = (volatile LAS unsigned*)(lds + LDS_BAR_OFF);
    xcd_barrier_post(bar, bst);
    phase0(P, smem);
    if (P.out == nullptr) grid.sync();
    xcd_barrier(bar, bst);
#pragma unroll 1
    for (int l = 0; l < 2; ++l) {
        pg8::Gemm gm;
        bf16_t* HB = l ? HB1 : HB0; bf16_t* HBn = l ? HB0 : HB1;
        if (l == 0) {
            constexpr int gs1 = 216;
            {
                pg8::Gemm g1{HB, (const bf16_t*)(ws + O_W1), NTOK, 6144, 2048};
                EpiScIn e{SS, (bf16_t*)(ws + O_BG), (bf16_t*)(ws + O_U), P.out + OO_SCP, P.out + OO_SCS};
                if (c < gs1) { S.init(g1.M, g1.N, gs1, opqs(c)); pg8::gemm_phase(lds, g1, S, e); }
            }
            if (c >= gs1)
#pragma unroll 1
            for (int l2 = 0; l2 < 2; ++l2) {
                pg8::Gemm gp{(const bf16_t*)(ws + O_PB) + (size_t)l2 * NTOK * 256, (const bf16_t*)(ws + O_WP + l2 * SZ_WP), NTOK, 2048, 256};
                EpiPlain e{(bf16_t*)(ws + O_PP) + (size_t)l2 * NTOK * DM};
                S.init(gp.M, gp.N, G - gs1, opqs(c) - gs1); pg8::gemm_phase(lds, gp, S, e);
            }
            xcd_barrier(bar, bst);
            sc_conv_phase(P);
            xcd_barrier(bar, bst);
            gm = pg8::Gemm{(const bf16_t*)(ws + O_BG), (const bf16_t*)(ws + O_W2), NPR, 2048, 2048};
        } else {
            {
                pg8::Gemm g6{HB, (const bf16_t*)(ws + O_W6), NTOK, NSSDP, 2048};
                EpiSsdIn e{SS + 3 * NTOK, (bf16_t*)(ws + O_Z), (bf16_t*)(ws + O_XBC), (float*)(ws + O_DT), P.out + OO_SSDCP, P.out + OO_SSDCS};
                if (c < 246) { S.init(g6.M, g6.N, 246, opqs(c)); pg8::gemm_phase(lds, g6, S, e); }
                else cvt_jobs(P, smem, 1u << 12, (c - 246) * 8 + (opq(threadIdx.x) >> 6), 10 * 8);
            }
            xcd_barrier(bar, bst);
            for (int it = c; it < 512 + 1024; it += G) { if (it < 512) ssd_prompt_item(P, it, smem); else ssd_sample_item(P, it - 512, smem); }
            xcd_barrier(bar, bst);
            for (int it = c; it < 256; it += G) ssd_scan_item(P, it, smem);
            xcd_barrier(bar, bst);
            ssd_gate_phase(P);
            xcd_barrier(bar, bst);
            gm = pg8::Gemm{(const bf16_t*)(ws + O_A7), (const bf16_t*)(ws + O_W7), NPR, 2048, 4096};
        }
        float* ss_l = SS + 3 * l * NTOK;
        {
            const float* hin_main = l ? (const float*)H : P.in[I_XP];
            const float* hin_small = l ? (const float*)H : P.in[I_XS] - (size_t)NPR * DM;
            EpiRes<0> e{H, HB, ss_l + NTOK, nullptr, nullptr, hin_main};
            S.init(gm.M, gm.N, G, opqs(c)); pg8::gemm_phase(lds, gm, S, e);
            for (int u = c; u < 256; u += G) small_gemm_res<0>(smem, gm.A + (size_t)NPR * gm.K, gm.Bt, gm.K, H, hin_small, HB, ss_l + NTOK, nullptr, nullptr, u);
        }
        xcd_barrier(bar, bst);
        {
            pg8::Gemm g3{HB, (const bf16_t*)(ws + O_W3 + l * SZ_W3), NTOK, 11264, 2048};
            EpiGateUp e{ss_l + NTOK, (bf16_t*)(ws + O_ACT)};
            constexpr int gg = 228;
            if (c < gg) { S.init(g3.M, g3.N, gg, opqs(c)); pg8::gemm_phase(lds, g3, S, e); }
            else cvt_jobs(P, smem, l == 0 ? ((1u << 5) | (1u << 7) | (1u << 11) | (1u << 4)) : ((1u << 6) | (1u << 8)), (c - gg) * 8 + (opq(threadIdx.x) >> 6), (G - gg) * 8);
        }
        xcd_barrier(bar, bst);
        {
            pg8::Gemm g4{(const bf16_t*)(ws + O_ACT), (const bf16_t*)(ws + O_W4 + l * SZ_W4), NPR, 2048, DFF};
            EpiRes<0> e{H, HB, ss_l + 2 * NTOK, nullptr, nullptr, H};
            S.init(g4.M, g4.N, G, opqs(c)); pg8::gemm_phase(lds, g4, S, e);
            for (int u = c; u < 256; u += G) small_gemm_res<0>(smem, g4.A + (size_t)NPR * g4.K, g4.Bt, g4.K, H, H, HB, ss_l + 2 * NTOK, nullptr, nullptr, u);
        }
        xcd_barrier(bar, bst);
        {
            pg8::Gemm g5{HB, (const bf16_t*)(ws + O_W5 + l * SZ_W5), NPR, 2048, 2048};
            EpiRes<1> e{H, HBn, ss_l + 3 * NTOK, ss_l + 2 * NTOK, (const bf16_t*)(ws + O_PP) + (size_t)l * NTOK * DM, H};
            S.init(g5.M, g5.N, G, opqs(c)); pg8::gemm_phase(lds, g5, S, e);
            for (int u = c; u < 256; u += G) small_gemm_res<1>(smem, g5.A + (size_t)NPR * g5.K, g5.Bt, g5.K, H, H, HBn, ss_l + 3 * NTOK, ss_l + 2 * NTOK, e.PPl, u);
        }
        xcd_barrier(bar, bst);
    }
    final_phase(P);
}

extern "C" void kernel_launch(void* const* d_in, const int* in_sizes, int n_in, void* d_out, int out_size, void* d_ws, size_t ws_size, hipStream_t stream) {
    static int grid_blocks = 0;
    if (grid_blocks == 0) {
        if (n_in != 27 || ws_size < WS_END) { fprintf(stderr, "kernel_launch: need 27 inputs and %zu B workspace (got %d, %zu)\n", (size_t)WS_END, n_in, ws_size); grid_blocks = -1; return; }
        int dev = 0, cus = 0, per_cu = 0;
        hipGetDevice(&dev);
        hipDeviceGetAttribute(&cus, hipDeviceAttributeMultiprocessorCount, dev);
        if (hipFuncSetAttribute((const void*)hybrid_mega, hipFuncAttributeMaxDynamicSharedMemorySize, LDS_BYTES) != hipSuccess) { fprintf(stderr, "kernel_launch: hipFuncSetAttribute failed\n"); grid_blocks = -1; return; }
        if (hipOccupancyMaxActiveBlocksPerMultiprocessor(&per_cu, (const void*)hybrid_mega, 512, LDS_BYTES) != hipSuccess || per_cu < 1) { fprintf(stderr, "kernel_launch: occupancy query failed (%d)\n", per_cu); grid_blocks = -1; return; }
        if (cus < 256) { fprintf(stderr, "kernel_launch: built for a 256-CU device (got %d CUs)\n", cus); grid_blocks = -1; return; }
        grid_blocks = 256;
    }
    if (grid_blocks < 0) return;
    Params p; memset(&p, 0, sizeof(p));
    for (int i = 0; i < 27; ++i) p.in[i] = (const float*)d_in[i];
    p.out = (float*)d_out; p.ws = (unsigned char*)d_ws;
    (void)hipMemsetAsync((unsigned char*)d_ws + O_BAR, 0, BAR_BYTES, stream);
    void* args[] = {&p};
    hipError_t e = hipLaunchCooperativeKernel((const void*)hybrid_mega, dim3(grid_blocks), dim3(512), args, LDS_BYTES, stream);
    if (e != hipSuccess) fprintf(stderr, "cooperative launch failed: %s (grid %d)\n", hipGetErrorString(e), grid_blocks);
}
```
